# Optimizing an MI355X kernel written in HIP

```python
import jax, jax.numpy as jnp
from jax import lax
import numpy as np

D_MODEL = 2048
BATCH = 2
SEQ = 8192
DEPTH = 4

N_MIXERS = 2
N_NSA_LAYERS = (DEPTH + N_MIXERS - 1) // N_MIXERS
N_HGRN_LAYERS = DEPTH // N_MIXERS
RMS_EPS = 1e-6
NEG = -1e30
BIG = 1e30

NSA_HEADS = 16
NSA_KV_GROUPS = 4
NSA_HEAD_DIM = 128
NSA_REP = NSA_HEADS // NSA_KV_GROUPS
CMP_BLOCK = 32
CMP_STRIDE = 16
CMP_HIDDEN = NSA_HEAD_DIM
SEL_BLOCK = 64
SEL_TOPK = 16
WINDOW = 512
Q_BLOCK = 128
SEL_Q_CHUNK = 16
ROPE_THETA = 500000.0
ROPE_DIM = NSA_HEAD_DIM // 4
NSA_KVW = NSA_KV_GROUPS * NSA_HEAD_DIM
NSA_IN = NSA_HEADS * NSA_HEAD_DIM + 6 * NSA_KVW + 3 * NSA_HEADS + NSA_HEADS * NSA_HEAD_DIM

HGRN_HEADS = 16
HGRN_F_DIM = 128
HGRN_I_DIM = D_MODEL // HGRN_HEADS
HGRN_CHUNK = 32
HGRN_IN = 2 * HGRN_HEADS * HGRN_F_DIM + 2 * HGRN_HEADS * HGRN_I_DIM

kernel_name = "nsa_hgrn2_interleaved_hybrid"


def rmsnorm(x, w):
    xf = x.astype(jnp.float32)
    y = xf * lax.rsqrt(jnp.mean(xf * xf, axis=-1, keepdims=True) + RMS_EPS)
    return (y * w.astype(jnp.float32)).astype(x.dtype)


def partial_rope(t, pos):
    half = ROPE_DIM // 2
    inv = ROPE_THETA ** (-jnp.arange(half, dtype=jnp.float32) / half)
    ang = pos.astype(jnp.float32)[..., None] * inv
    cos = jnp.cos(ang)[:, :, None, :]
    sin = jnp.sin(ang)[:, :, None, :]
    tr = t[..., :ROPE_DIM].astype(jnp.float32)
    t1, t2 = tr[..., :half], tr[..., half:]
    rot = jnp.concatenate([t1 * cos - t2 * sin, t2 * cos + t1 * sin], axis=-1)
    return jnp.concatenate([rot.astype(t.dtype), t[..., ROPE_DIM:]], axis=-1)


def compress_blocks(t, pos_emb, w1, w2):
    S = t.shape[2]
    n_cmp = (S - CMP_BLOCK) // CMP_STRIDE + 1
    idx = jnp.arange(n_cmp)[:, None] * CMP_STRIDE + jnp.arange(CMP_BLOCK)[None, :]
    blocks = t[:, :, idx, :] + pos_emb
    hid = jax.nn.silu(jnp.einsum('bgnld,ldh->bgnh', blocks, w1))
    return jnp.einsum('bgnh,he->bgne', hid, w2)


def nsa_mixer(h, pos, w_in, ck_pos, ck_w1, ck_w2, cv_pos, cv_w1, cv_w2, w_out):
    B, S, _ = h.shape
    H, G, R, d = NSA_HEADS, NSA_KV_GROUPS, NSA_REP, NSA_HEAD_DIM
    scale = d ** -0.5
    proj = h @ w_in
    cuts = [int(c) for c in np.cumsum([H * d] + [NSA_KVW] * 6 + [3 * H])]
    q, kc, vc, ks, vs, kw, vw, gl, z = jnp.split(proj, cuts, axis=-1)

    q = partial_rope(q.reshape(B, S, H, d), pos)
    qg = q.reshape(B, S, G, R, d).transpose(0, 2, 3, 1, 4)

    def kv_layout(t, rotate):
        t = t.reshape(B, S, G, d)
        if rotate:
            t = partial_rope(t, pos)
        return t.transpose(0, 2, 1, 3)

    k_cmp = compress_blocks(kv_layout(kc, True), ck_pos, ck_w1, ck_w2)
    v_cmp = compress_blocks(kv_layout(vc, False), cv_pos, cv_w1, cv_w2)
    k_sel, v_sel = kv_layout(ks, True), kv_layout(vs, False)
    k_win, v_win = kv_layout(kw, True), kv_layout(vw, False)

    n_cmp = k_cmp.shape[2]
    n_sel = S // SEL_BLOCK
    cmp_start = jnp.arange(n_cmp) * CMP_STRIDE
    cmp_end = cmp_start + CMP_BLOCK - 1
    sel_ids = jnp.arange(n_sel)
    overlap = ((cmp_start[:, None] < (sel_ids[None, :] + 1) * SEL_BLOCK)
               & ((cmp_start + CMP_BLOCK)[:, None] > sel_ids[None, :] * SEL_BLOCK)).astype(jnp.float32)

    kw_pad = jnp.pad(k_win, ((0, 0), (0, 0), (WINDOW, 0), (0, 0)))
    vw_pad = jnp.pad(v_win, ((0, 0), (0, 0), (WINDOW, 0), (0, 0)))
    span = WINDOW + Q_BLOCK

    nqb = S // Q_BLOCK
    q_blocks = qg.reshape(B, G, R, nqb, Q_BLOCK, d).transpose(3, 0, 1, 2, 4, 5)
    starts = jnp.arange(nqb, dtype=jnp.int32) * Q_BLOCK

    def cmp_win_step(inp):
        qb, s0 = inp
        t = s0 + jnp.arange(Q_BLOCK)
        sc = jnp.einsum('bgrqd,bgnd->bgrqn', qb, k_cmp).astype(jnp.float32) * scale
        mc = cmp_end[None, :] <= t[:, None]
        pc = jax.nn.softmax(jnp.where(mc, sc, NEG), axis=-1) * mc
        o_c = jnp.einsum('bgrqn,bgnd->bgrqd', pc.astype(v_cmp.dtype), v_cmp)
        imp = jnp.einsum('bgrqn,nk->bgqk', pc, overlap)
        kb = lax.dynamic_slice_in_dim(kw_pad, s0, span, axis=2)
        vb = lax.dynamic_slice_in_dim(vw_pad, s0, span, axis=2)
        kp = s0 - WINDOW + jnp.arange(span)
        mw = (kp[None, :] <= t[:, None]) & (kp[None, :] > t[:, None] - WINDOW) & (kp[None, :] >= 0)
        sw = jnp.einsum('bgrqd,bgkd->bgrqk', qb, kb).astype(jnp.float32) * scale
        pw = jax.nn.softmax(jnp.where(mw, sw, NEG), axis=-1)
        o_w = jnp.einsum('bgrqk,bgkd->bgrqd', pw.astype(vb.dtype), vb)
        return o_c, o_w, imp

    o_c, o_w, imp = lax.map(cmp_win_step, (q_blocks, starts))

    def from_blocks(o):
        return o.transpose(1, 0, 4, 2, 3, 5).reshape(B, S, H, d)

    o_cmp, o_win = from_blocks(o_c), from_blocks(o_w)
    imp = imp.transpose(1, 2, 0, 3, 4).reshape(B, G, S, n_sel)

    tpos = jnp.arange(S)
    cur = tpos // SEL_BLOCK
    valid = sel_ids[None, :] <= cur[:, None]
    forced = (sel_ids[None, :] == 0) | (sel_ids[None, :] == cur[:, None]) | (sel_ids[None, :] == cur[:, None] - 1)
    score = jnp.where(valid, jnp.where(forced, BIG, imp), NEG)
    n_top = min(SEL_TOPK, n_sel)
    _, sel_idx = lax.top_k(score, n_top)

    k_blk = k_sel.reshape(B, G, n_sel, SEL_BLOCK, d)
    v_blk = v_sel.reshape(B, G, n_sel, SEL_BLOCK, d)
    nsc = S // SEL_Q_CHUNK
    q_chunks = qg.reshape(B, G, R, nsc, SEL_Q_CHUNK, d).transpose(3, 0, 1, 2, 4, 5)
    idx_chunks = sel_idx.reshape(B, G, nsc, SEL_Q_CHUNK, n_top).transpose(2, 0, 1, 3, 4)
    c_starts = jnp.arange(nsc, dtype=jnp.int32) * SEL_Q_CHUNK
    gather = jax.vmap(jax.vmap(lambda tb, ib: tb[ib]))

    def sel_step(inp):
        qc, ic, s0 = inp
        t = s0 + jnp.arange(SEL_Q_CHUNK)
        kg = gather(k_blk, ic)
        vg = gather(v_blk, ic)
        keypos = ic[..., None] * SEL_BLOCK + jnp.arange(SEL_BLOCK)
        m = keypos <= t[None, None, :, None, None]
        s = jnp.einsum('bgrqd,bgqnld->bgrqnl', qc, kg).astype(jnp.float32) * scale
        s = jnp.where(m[:, :, None], s, NEG).reshape(B, G, R, SEL_Q_CHUNK, n_top * SEL_BLOCK)
        p = jax.nn.softmax(s, axis=-1).reshape(B, G, R, SEL_Q_CHUNK, n_top, SEL_BLOCK)
        return jnp.einsum('bgrqnl,bgqnld->bgrqd', p.astype(vg.dtype), vg)

    o_s = lax.map(sel_step, (q_chunks, idx_chunks, c_starts))
    o_sel = from_blocks(o_s)

    g = jax.nn.sigmoid(gl.astype(jnp.float32)).reshape(B, S, 3, H)[..., None]
    o = (g[:, :, 0] * o_cmp.astype(jnp.float32) + g[:, :, 1] * o_sel.astype(jnp.float32)
         + g[:, :, 2] * o_win.astype(jnp.float32))
    o = o.reshape(B, S, H * d) * jax.nn.silu(z.astype(jnp.float32))
    return o.astype(h.dtype) @ w_out


def hgrn2_mixer(h, lb, w_in, gnorm_w, w_out):
    B, S, _ = h.shape
    H, Df, Di, C = HGRN_HEADS, HGRN_F_DIM, HGRN_I_DIM, HGRN_CHUNK
    proj = h @ w_in
    q, f, i, z = jnp.split(proj, [H * Df, 2 * H * Df, 2 * H * Df + H * Di], axis=-1)
    fl = f.astype(jnp.float32)
    lb = lb.astype(jnp.float32)
    log_f = jnp.logaddexp(jnp.log(lb), jnp.log1p(-lb) + jax.nn.log_sigmoid(fl))
    k = (1.0 - lb) * jax.nn.sigmoid(-fl)
    q = jax.nn.silu(q.astype(jnp.float32))
    n_chunks = S // C

    def to_chunks(t, dim):
        return t.reshape(B, n_chunks, C, H, dim).transpose(1, 0, 3, 2, 4)

    xs = (to_chunks(q, Df), to_chunks(k, Df), to_chunks(i.astype(jnp.float32), Di), to_chunks(log_f, Df))
    tri = jnp.tril(jnp.ones((C, C), dtype=bool))

    def step(state, inp):
        qc, kc, ic, gc = inp
        b = jnp.cumsum(gc, axis=2)
        diff = b[:, :, :, None, :] - b[:, :, None, :, :]
        decay = jnp.exp(jnp.where(tri[None, None, :, :, None], diff, -jnp.inf))
        att = jnp.einsum('bhtd,bhtsd,bhsd->bhts', qc, decay, kc)
        o = jnp.einsum('bhts,bhsi->bhti', att, ic) + jnp.einsum('bhtd,bhdi->bhti', qc * jnp.exp(b), state)
        b_last = b[:, :, -1:, :]
        new_state = (jnp.exp(b_last[:, :, 0, :])[..., None] * state
                     + jnp.einsum('bhsd,bhsi->bhdi', kc * jnp.exp(b_last - b), ic))
        return new_state, o

    state0 = jnp.zeros((B, H, Df, Di), jnp.float32)
    _, o = lax.scan(step, state0, xs)
    o = o.transpose(1, 0, 3, 2, 4).reshape(B, S, H, Di)
    o = o * lax.rsqrt(jnp.mean(o * o, axis=-1, keepdims=True) + RMS_EPS) * gnorm_w.astype(jnp.float32)
    o = o * jax.nn.silu(z.astype(jnp.float32).reshape(B, S, H, Di))
    return o.reshape(B, S, H * Di).astype(h.dtype) @ w_out


def setup_inputs(seed: int = 0) -> dict:
    key = jax.random.key(seed)
    ks = jax.random.split(key, 20)
    f32 = jnp.float32
    D, d, l = D_MODEL, NSA_HEAD_DIM, CMP_BLOCK
    offset = jax.random.randint(ks[0], (BATCH,), 0, 4096, dtype=jnp.int32)
    positions = offset[:, None] + jnp.arange(SEQ, dtype=jnp.int32)[None, :]
    return {
        "x": jax.random.normal(ks[1], (BATCH, SEQ, D), f32),
        "positions": positions,
        "norm_w": 1.0 + 0.01 * jax.random.normal(ks[2], (DEPTH, D), f32),
        "final_norm_w": 1.0 + 0.01 * jax.random.normal(ks[3], (D,), f32),
        "nsa_w_in": jax.random.normal(ks[4], (N_NSA_LAYERS, D, NSA_IN), f32) * D ** -0.5,
        "nsa_ck_pos": 0.02 * jax.random.normal(ks[5], (N_NSA_LAYERS, l, d), f32),
        "nsa_ck_w1": jax.random.normal(ks[6], (N_NSA_LAYERS, l, d, CMP_HIDDEN), f32) * (l * d) ** -0.5,
        "nsa_ck_w2": jax.random.normal(ks[7], (N_NSA_LAYERS, CMP_HIDDEN, d), f32) * CMP_HIDDEN ** -0.5,
        "nsa_cv_pos": 0.02 * jax.random.normal(ks[8], (N_NSA_LAYERS, l, d), f32),
        "nsa_cv_w1": jax.random.normal(ks[9], (N_NSA_LAYERS, l, d, CMP_HIDDEN), f32) * (l * d) ** -0.5,
        "nsa_cv_w2": jax.random.normal(ks[10], (N_NSA_LAYERS, CMP_HIDDEN, d), f32) * CMP_HIDDEN ** -0.5,
        "nsa_w_out": jax.random.normal(ks[11], (N_NSA_LAYERS, NSA_HEADS * d, D), f32) * (NSA_HEADS * d) ** -0.5,
        "hgrn_w_in": jax.random.normal(ks[12], (N_HGRN_LAYERS, D, HGRN_IN), f32) * D ** -0.5,
        "hgrn_lb_logits": jax.random.normal(ks[13], (N_HGRN_LAYERS, HGRN_HEADS * HGRN_F_DIM), f32),
        "hgrn_gnorm_w": 1.0 + 0.01 * jax.random.normal(ks[14], (N_HGRN_LAYERS, HGRN_I_DIM), f32),
        "hgrn_w_out": jax.random.normal(ks[15], (N_HGRN_LAYERS, HGRN_HEADS * HGRN_I_DIM, D), f32) * (HGRN_HEADS * HGRN_I_DIM) ** -0.5,
    }


def reference(x, positions, norm_w, final_norm_w, nsa_w_in, nsa_ck_pos, nsa_ck_w1, nsa_ck_w2,
              nsa_cv_pos, nsa_cv_w1, nsa_cv_w2, nsa_w_out, hgrn_w_in, hgrn_lb_logits,
              hgrn_gnorm_w, hgrn_w_out):
    p_lb = jax.nn.softmax(hgrn_lb_logits.astype(jnp.float32), axis=0)
    cum = jnp.cumsum(p_lb, axis=0)
    lower_bounds = cum - cum[0]
    for layer in range(DEPTH):
        hn = rmsnorm(x, norm_w[layer])
        j = layer // N_MIXERS
        if layer % N_MIXERS == 0:
            y = nsa_mixer(hn, positions, nsa_w_in[j], nsa_ck_pos[j], nsa_ck_w1[j], nsa_ck_w2[j],
                          nsa_cv_pos[j], nsa_cv_w1[j], nsa_cv_w2[j], nsa_w_out[j])
        else:
            y = hgrn2_mixer(hn, lower_bounds[j], hgrn_w_in[j], hgrn_gnorm_w[j], hgrn_w_out[j])
        x = x + y.astype(x.dtype)
    return rmsnorm(x, final_norm_w)
```

```cpp
#include <hip/hip_runtime.h>
#include <hip/hip_cooperative_groups.h>
#include <cstdio>
namespace cg = cooperative_groups;
__device__ __forceinline__ int get_tid() { int t = threadIdx.x; asm volatile("" : "+v"(t)); return t; }
#ifndef ONE_LAUNCH
#define ONE_LAUNCH 0
#endif
#ifndef SANITIZE
#define SANITIZE 0
#endif
namespace pg8 {
#define PG8_LAS __attribute__((address_space(3)))
typedef unsigned short bf16_t;
typedef short bf16x8 __attribute__((ext_vector_type(8)));
typedef float f32x4 __attribute__((ext_vector_type(4)));
typedef unsigned u32x4 __attribute__((ext_vector_type(4)));
constexpr int BM = 256, BK = 64, HALF = 128, HTB = HALF * BK * 2  , STAGE_BYTES = 8 * HTB, NXCD = 8, WGM = 8;

__host__ __device__ __forceinline__ int lds_byte(int r, int c) { const int st = (r >> 4) * 2 + (c >> 5), rr = r & 15, cc = c & 31, ob = rr * 64 + cc * 2; return st * 1024 + (ob ^ (((ob >> 9) & 1) << 5)); }
__host__ __device__ __forceinline__ void stage_rc(int b, int& R, int& C) { const int st = b / 1024, sb = b % 1024, swz = sb ^ (((sb >> 9) & 1) << 5); R = (st >> 1) * 16 + swz / 64; C = (st & 1) * 32 + (swz % 64) / 2; }
__host__ __device__ __forceinline__ int perm32(int rho) { const int n = rho >> 4, i = rho & 15; return 8 * (i >> 2) + 4 * n + (i & 3); }

struct Unit { int pm, pn; };
struct Gemm { const bf16_t* A; const bf16_t* Bt; int M, N, K; };

struct StaticOrder {
    int nM, nN, nwg, G, c;
    __host__ __device__ void init(int M, int N, int G_, int c_) { nM = M / BM; nN = N / BM; nwg = nM * nN; G = G_; c = c_; }
    __host__ __device__ bool next(int i, Unit& u) const {
        const long L = (long)i * G + c; if (L >= nwg) return false;
        int wgid = (int)L; { const int q = nwg / NXCD, r = nwg % NXCD, xcd = wgid % NXCD, off = wgid / NXCD; wgid = (xcd < r ? xcd * (q + 1) : r * (q + 1) + (xcd - r) * q) + off; }
        const int nig = WGM * nN, gid = wgid / nig, fm = gid * WGM, gsz = (nM - fm) < WGM ? (nM - fm) : WGM;
        u.pm = fm + ((wgid % nig) % gsz); u.pn = (wgid % nig) / gsz; return true;
    }
    __device__ __forceinline__ void a_ready(const Unit&) const {}
    __device__ __forceinline__ void done(const Unit&) const {}
};
__device__ __forceinline__ unsigned cvt_pk_bf16(float lo, float hi) { unsigned r; asm volatile("v_cvt_pk_bf16_f32 %0, %1, %2" : "=v"(r) : "v"(lo), "v"(hi)); return r; }
typedef float f32x2 __attribute__((ext_vector_type(2)));
template <class Epi, class Sched, bool STAMP = false>
__device__ __forceinline__ void gemm_phase(PG8_LAS unsigned char* lds, const Gemm g, const Sched& S, const Epi& E, unsigned long long* stamps) {
    const int tid = get_tid(), wid = __builtin_amdgcn_readfirstlane(tid >> 6), lane = tid & 63, wr = wid >> 2, wc = wid & 3, fr = lane & 15, fq = lane >> 4;
    const int K = g.K, nt = K / BK;
    int ts_lo = 0, ts_hi = 0, nts = 0; const unsigned long long rt_entry = STAMP ? (unsigned long long)wall_clock64() : 0ull;
#define PG8_STAMP() do { if (STAMP && wid == 0 && nts < 64) { const unsigned long long _c = (unsigned long long)clock64(); \
        ts_lo = (lane == nts) ? (int)(unsigned)_c : ts_lo; ts_hi = (lane == nts) ? (int)(unsigned)(_c >> 32) : ts_hi; ++nts; } } while (0)
    PG8_STAMP();
    unsigned voffA[2], voffB[2];
#pragma unroll
    for (int i = 0; i < 2; ++i) { int R, C; stage_rc(tid * 16 + i * 8192, R, C); const int Rb = Epi::PERM ? ((R & ~31) + perm32(R & 31)) : R;
        voffA[i] = (unsigned)(R * K + C) * 2u; voffB[i] = (unsigned)(Rb * K + C) * 2u; }
    const size_t kstep = (size_t)(BK * 2);
    const size_t hstep = (size_t)HALF * K * 2;
    const size_t tstep = 2 * hstep;
    const unsigned ldsw = (unsigned)wid * 1024u;
    const int aoff = lds_byte(wr * 64 + fr, fq * 8), boff = lds_byte(wc * 32 + fr, fq * 8);
#define PG8_SA(b, h) (((b) * 2 + (h)) * HTB)
#define PG8_SB(b, h) ((4 + (b) * 2 + (h)) * HTB)
#define PG8_STAGE(bufoff, gbase, voff) do { _Pragma("unroll") for (int _i = 0; _i < 2; ++_i) \
        __builtin_amdgcn_global_load_lds((const unsigned*)((const char*)(gbase) + (voff)[_i]), (PG8_LAS unsigned*)(lds + (bufoff) + ldsw + _i * 8192), 16, 0, 0); } while (0)
#define PG8_LDA(dst, b, h) do { _Pragma("unroll") for (int m = 0; m < 4; ++m) _Pragma("unroll") for (int k = 0; k < 2; ++k) dst[m][k] = *(const PG8_LAS bf16x8*)(lds + PG8_SA(b, h) + aoff + m * 2048 + k * 1024); } while (0)
#define PG8_LDB(dst, b, h) do { _Pragma("unroll") for (int n = 0; n < 2; ++n) _Pragma("unroll") for (int k = 0; k < 2; ++k) dst[n][k] = *(const PG8_LAS bf16x8*)(lds + PG8_SB(b, h) + boff + n * 2048 + k * 1024); } while (0)
#define PG8_MMA(ai, bj, At, Bt) do { __builtin_amdgcn_s_setprio(1); _Pragma("unroll") for (int m = 0; m < 4; ++m) _Pragma("unroll") for (int n = 0; n < 2; ++n) _Pragma("unroll") for (int k = 0; k < 2; ++k) \
        acc[ai][bj][m][n] = __builtin_amdgcn_mfma_f32_16x16x32_bf16(Bt[n][k], At[m][k], acc[ai][bj][m][n], 0, 0, 0); __builtin_amdgcn_s_setprio(0); } while (0)
#define PG8_WAIT_V(n) asm volatile("s_waitcnt vmcnt(" #n ")" ::: "memory")
#define PG8_WAIT_L(n) asm volatile("s_waitcnt lgkmcnt(" #n ")" ::: "memory")
#define PG8_BAR __builtin_amdgcn_s_barrier()
#define PG8_SCHED __builtin_amdgcn_sched_barrier(0)
    Unit cur, nxt; int ui = 0;
    if (!S.next(0, cur)) return;
    f32x4 acc[2][2][4][2];
#pragma unroll
    for (int a = 0; a < 2; ++a)
#pragma unroll
        for (int b = 0; b < 2; ++b)
#pragma unroll
            for (int m = 0; m < 4; ++m)
#pragma unroll
                for (int n = 0; n < 2; ++n) acc[a][b][m][n] = (f32x4){0.f, 0.f, 0.f, 0.f};
    bf16x8 At[4][2], B0[2][2], B1[2][2];
    const char* cA = (const char*)g.A + (size_t)cur.pm * tstep; const char* cB = (const char*)g.Bt + (size_t)cur.pn * tstep;
    S.a_ready(cur);
    PG8_STAGE(PG8_SB(0, 0), cB, voffB); PG8_STAGE(PG8_SA(0, 0), cA, voffA); PG8_STAGE(PG8_SB(0, 1), cB + hstep, voffB); PG8_STAGE(PG8_SA(0, 1), cA + hstep, voffA);
    if (wr == 1) PG8_BAR;
    PG8_WAIT_V(4); PG8_BAR;
    PG8_STAGE(PG8_SB(1, 0), cB + kstep, voffB); PG8_STAGE(PG8_SA(1, 0), cA + kstep, voffA); PG8_STAGE(PG8_SB(1, 1), cB + hstep + kstep, voffB);
    PG8_WAIT_V(6); PG8_BAR;
    PG8_STAMP();
    for (;;) {
        const bool has_next = S.next(ui + 1, nxt);
        const char* nA = has_next ? (const char*)g.A + (size_t)nxt.pm * tstep : cA; const char* nB = has_next ? (const char*)g.Bt + (size_t)nxt.pn * tstep : cB;
        for (int t = 0; t < nt; t += 2) {
            const bool last = (t == nt - 2);
            const char* a1 = cA + (size_t)(t + 1) * kstep;
            const char* a2 = last ? nA : cA + (size_t)(t + 2) * kstep; const char* b2 = last ? nB : cB + (size_t)(t + 2) * kstep;
            const char* a3 = a2 + kstep; const char* b3 = b2 + kstep;
            if (last && has_next) S.a_ready(nxt);
            PG8_LDB(B0, 0, 0); PG8_SCHED; PG8_LDA(At, 0, 0); PG8_STAGE(PG8_SA(1, 1), a1 + hstep, voffA);
            PG8_WAIT_L(8); PG8_BAR; PG8_WAIT_L(0); PG8_MMA(0, 0, At, B0); PG8_BAR; PG8_SCHED;
            PG8_LDB(B1, 0, 1); PG8_STAGE(PG8_SB(0, 0), b2, voffB);
            PG8_BAR; PG8_WAIT_L(0); PG8_MMA(0, 1, At, B1); PG8_BAR;
            PG8_LDA(At, 0, 1); PG8_STAGE(PG8_SA(0, 0), a2, voffA);
            PG8_BAR; PG8_WAIT_L(0); PG8_MMA(1, 0, At, B0); PG8_BAR; PG8_SCHED;
            PG8_STAGE(PG8_SB(0, 1), b2 + hstep, voffB);
            PG8_WAIT_V(6); PG8_BAR; PG8_MMA(1, 1, At, B1); PG8_BAR;
            PG8_LDB(B0, 1, 0); PG8_SCHED; PG8_LDA(At, 1, 0); PG8_STAGE(PG8_SA(0, 1), a2 + hstep, voffA);
            PG8_WAIT_L(8); PG8_BAR; PG8_WAIT_L(0); PG8_MMA(0, 0, At, B0); PG8_BAR; PG8_SCHED;
            PG8_LDB(B1, 1, 1); PG8_STAGE(PG8_SB(1, 0), b3, voffB);
            PG8_BAR; PG8_WAIT_L(0); PG8_MMA(0, 1, At, B1); PG8_BAR;
            PG8_LDA(At, 1, 1); PG8_STAGE(PG8_SA(1, 0), a3, voffA);
            PG8_BAR; PG8_WAIT_L(0); PG8_MMA(1, 0, At, B0); PG8_BAR; PG8_SCHED;
            PG8_STAGE(PG8_SB(1, 1), b3 + hstep, voffB);
            PG8_WAIT_V(6); PG8_BAR; PG8_MMA(1, 1, At, B1); PG8_BAR;
        }
        PG8_STAMP();
        if constexpr (!Epi::AFTER_DRAIN) { E(acc, cur, wr, wc, fr, fq); S.done(cur); }
        PG8_STAMP();
        if (!has_next) break;
#pragma unroll
        for (int a = 0; a < 2; ++a)
#pragma unroll
            for (int b = 0; b < 2; ++b)
#pragma unroll
                for (int m = 0; m < 4; ++m)
#pragma unroll
                    for (int n = 0; n < 2; ++n) acc[a][b][m][n] = (f32x4){0.f, 0.f, 0.f, 0.f};
        cur = nxt; cA = nA; cB = nB; ++ui;
    }
    PG8_WAIT_V(0);
    if (wr == 0) PG8_BAR;
    PG8_BAR;
    if constexpr (Epi::AFTER_DRAIN) { E.fused(acc, cur, wr, wc, fr, fq, lds, wid, lane); S.done(cur); }
    PG8_STAMP();
    if (STAMP && wid == 0) { stamps[lane] = lane < nts ? (((unsigned long long)(unsigned)ts_hi << 32) | (unsigned)ts_lo) : 0ull;
        if (lane == 62) stamps[62] = rt_entry; if (lane == 63) stamps[63] = (unsigned long long)wall_clock64(); }
#undef PG8_STAMP
#undef PG8_SA
#undef PG8_SB
#undef PG8_STAGE
#undef PG8_LDA
#undef PG8_LDB
#undef PG8_MMA
#undef PG8_WAIT_V
#undef PG8_WAIT_L
#undef PG8_BAR
#undef PG8_SCHED
}
}
using pg8::bf16_t; using pg8::bf16x8; using pg8::f32x4; using pg8::u32x4; using pg8::cvt_pk_bf16;
typedef short bf16x4 __attribute__((ext_vector_type(4)));
typedef unsigned u32x2 __attribute__((ext_vector_type(2)));

constexpr int NTOK = 16384, SEQ = 8192, DM = 2048, NBATCH = 2;
constexpr int NSA_NP = 7424, NSA_IN = 7216, HG_NP = 8192;
constexpr int Q0 = 0, KC0 = 2048, VC0 = 2560, KS0 = 3072, VS0 = 3584, KW0 = 4096, VW0 = 4608, Z0 = 5120, GL0 = 7168;
constexpr int NTHR = 512;
constexpr int LDS_BYTES = 131072;
constexpr float RMS_EPS = 1e-6f;
constexpr size_t WS_WIN = 0;
constexpr size_t WS_WOUT = WS_WIN + (size_t)8192 * 2048 * 2;
constexpr size_t WS_W1T = WS_WOUT + (size_t)2048 * 2048 * 2;
constexpr size_t WS_W2T = WS_W1T + (size_t)4 * 128 * 4096 * 2;
constexpr size_t WS_CBIAS = WS_W2T + (size_t)4 * 128 * 128 * 2;
constexpr size_t WS_LB = WS_CBIAS + 4096;
constexpr size_t WS_ROPE = WS_LB + (size_t)2 * 2048 * 4;
constexpr size_t WS_SSQ = WS_ROPE + (size_t)NTOK * 32 * 4;
constexpr size_t WS_XB = WS_SSQ + (size_t)5 * NTOK * 4;
constexpr size_t WS_PROJ = WS_XB + (size_t)NTOK * 2048 * 2;
constexpr size_t WS_OBUF = WS_PROJ + (size_t)NTOK * 8192 * 2;
constexpr size_t WS_KCMP = WS_OBUF + (size_t)NTOK * 2048 * 2;
constexpr size_t WS_VCMPT = WS_KCMP + (size_t)8 * 512 * 128 * 2;
constexpr size_t WS_VST = WS_VCMPT + (size_t)8 * 512 * 128 * 2;
constexpr size_t WS_VWT = WS_VST + (size_t)8 * 128 * 8192 * 2;
constexpr size_t WS_HSEG = WS_VWT + (size_t)8 * 128 * 8192 * 2;
constexpr int HSEG_STRIDE = 128 * 128 + 128;
constexpr size_t WS_END = WS_HSEG + (size_t)256 * HSEG_STRIDE * 4;

struct Params {
    const float* x; const int* pos; const float* norm_w; const float* fnorm_w;
    const float* nsa_w_in; const float* ck_pos; const float* ck_w1; const float* ck_w2;
    const float* cv_pos; const float* cv_w1; const float* cv_w2; const float* nsa_w_out;
    const float* hg_w_in; const float* hg_lb; const float* hg_gn; const float* hg_w_out;
    float* out; unsigned char* ws; int ph_lo, ph_hi, coop, pad;
};

__device__ __forceinline__ bf16_t f2bf(float f) { unsigned u = __float_as_uint(f); u += 0x7FFFu + ((u >> 16) & 1u); return (bf16_t)(u >> 16); }
__device__ __forceinline__ float bf2f(bf16_t b) { return __uint_as_float(((unsigned)b) << 16); }
__device__ __forceinline__ float bflo(unsigned w) { return __uint_as_float(w << 16); }
__device__ __forceinline__ float bfhi(unsigned w) { return __uint_as_float(w & 0xffff0000u); }
__device__ __forceinline__ f32x4 mfma16(bf16x8 a, bf16x8 b, f32x4 c) { return __builtin_amdgcn_mfma_f32_16x16x32_bf16(a, b, c, 0, 0, 0); }
__device__ __forceinline__ float sigmoidf_(float v) { return 1.0f / (1.0f + __expf(-v)); }
__device__ __forceinline__ float siluf_(float v) { return v / (1.0f + __expf(-v)); }
__device__ __forceinline__ bf16x8 pack8f(const float* v) { u32x4 w = {cvt_pk_bf16(v[0], v[1]), cvt_pk_bf16(v[2], v[3]), cvt_pk_bf16(v[4], v[5]), cvt_pk_bf16(v[6], v[7])}; return *reinterpret_cast<bf16x8*>(&w); }
__device__ __forceinline__ bf16x8 pack44(f32x4 a, f32x4 b) { u32x4 w = {cvt_pk_bf16(a[0], a[1]), cvt_pk_bf16(a[2], a[3]), cvt_pk_bf16(b[0], b[1]), cvt_pk_bf16(b[2], b[3])}; return *reinterpret_cast<bf16x8*>(&w); }

__device__ __forceinline__ int nsa_col(int n) { return n < 5120 ? n : (n < 7168 ? n + 48 : (n < 7216 ? n - 2048 : -1)); }
template <int MODE>
__device__ __forceinline__ void tconv(const float* __restrict__ src, int ldsrc, int nsrc, bf16_t* __restrict__ dst, int Kdim, int Ndst, const float* __restrict__ rowscale, float* tile, int blk, int nblk) {
    const int tid = get_tid(), nkt = Kdim / 64, nnt = Ndst / 64;
    for (int it = blk; it < nkt * nnt; it += nblk) {
        const int k0 = (it % nkt) * 64, n0 = (it / nkt) * 64;
        __syncthreads();
#pragma unroll
        for (int i = 0; i < 2; ++i) {
            const int kr = (tid >> 4) + 32 * i, c4 = (tid & 15) * 4, n = n0 + c4;
            const int sc = MODE == 1 ? nsa_col(n) : (n < nsrc ? n : -1);
            f32x4 v = {0.f, 0.f, 0.f, 0.f};
            if (sc >= 0) v = *(const f32x4*)(src + (size_t)(k0 + kr) * ldsrc + sc);
            if (rowscale) { const float s = rowscale[k0 + kr]; v = v * s; }
            tile[kr * 65 + c4 + 0] = v[0]; tile[kr * 65 + c4 + 1] = v[1]; tile[kr * 65 + c4 + 2] = v[2]; tile[kr * 65 + c4 + 3] = v[3];
        }
        __syncthreads();
        { const int nr = tid >> 3, k8 = (tid & 7) * 8; float v[8];
#pragma unroll
          for (int j = 0; j < 8; ++j) v[j] = tile[(k8 + j) * 65 + nr];
          *(bf16x8*)(dst + (size_t)(n0 + nr) * Kdim + k0 + k8) = pack8f(v); }
    }
    __syncthreads();
}

struct EpiNsaIn {
    static constexpr bool PERM = true, AFTER_DRAIN = false;
    bf16_t* proj; const float* ssq; const float* rope;
    __device__ __forceinline__ void operator()(const f32x4 (&acc)[2][2][4][2], const pg8::Unit& u, int wr, int wc, int fr, int fq) const {
        const int pn = u.pn;
        const bool is_rope = (pn < 10) || pn == 12 || pn == 13 || pn == 16 || pn == 17;
        const int mode = (pn >= 20 && pn < 28) ? 1 : (pn == 28 ? 2 : 0);
        const bool do_rope = is_rope && (wc == 0);
#pragma unroll
        for (int ai = 0; ai < 2; ++ai)
#pragma unroll
            for (int m = 0; m < 4; ++m) {
                const int row = u.pm * 256 + ai * 128 + wr * 64 + m * 16 + fr;
                const float rs = rsqrtf(ssq[row] * (1.0f / 2048.0f) + RMS_EPS);
                f32x4 c0 = {1.f, 1.f, 1.f, 1.f}, c1 = c0, s0 = {0.f, 0.f, 0.f, 0.f}, s1 = s0;
                if (do_rope) { const float* cp = rope + (size_t)row * 32 + 8 * (fq & 1); c0 = *(const f32x4*)cp; c1 = *(const f32x4*)(cp + 4); s0 = *(const f32x4*)(cp + 16); s1 = *(const f32x4*)(cp + 20);
                    if (fq < 2) { s0 = -s0; s1 = -s1; } }
#pragma unroll
                for (int bj = 0; bj < 2; ++bj) {
                    float v[8];
#pragma unroll
                    for (int j = 0; j < 4; ++j) { v[j] = acc[ai][bj][m][0][j] * rs; v[4 + j] = acc[ai][bj][m][1][j] * rs; }
                    if (do_rope) {
#pragma unroll
                        for (int e = 0; e < 8; ++e) { const float pr = __shfl_xor(v[e], 32); const float c = e < 4 ? c0[e & 3] : c1[e & 3], s = e < 4 ? s0[e & 3] : s1[e & 3]; v[e] = v[e] * c + pr * s; }
                    }
                    if (mode == 1) {
#pragma unroll
                        for (int e = 0; e < 8; ++e) v[e] = siluf_(v[e]);
                    } else if (mode == 2) {
#pragma unroll
                        for (int e = 0; e < 8; ++e) v[e] = sigmoidf_(v[e]);
                    }
                    *(bf16x8*)(proj + (size_t)row * NSA_NP + pn * 256 + bj * 128 + wc * 32 + 8 * fq) = pack8f(v);
                }
            }
    }
};
struct EpiHgIn {
    static constexpr bool PERM = true, AFTER_DRAIN = false;
    bf16_t* proj; const float* ssq; const float* lb;
    __device__ __forceinline__ void operator()(const f32x4 (&acc)[2][2][4][2], const pg8::Unit& u, int wr, int wc, int fr, int fq) const {
        const int pn = u.pn; const int mode = pn < 8 ? 1 : (pn < 16 ? 3 : (pn < 24 ? 0 : 1));
#pragma unroll
        for (int ai = 0; ai < 2; ++ai)
#pragma unroll
            for (int m = 0; m < 4; ++m) {
                const int row = u.pm * 256 + ai * 128 + wr * 64 + m * 16 + fr;
                const float rs = rsqrtf(ssq[row] * (1.0f / 2048.0f) + RMS_EPS);
#pragma unroll
                for (int bj = 0; bj < 2; ++bj) {
                    const int col = pn * 256 + bj * 128 + wc * 32 + 8 * fq;
                    float v[8];
#pragma unroll
                    for (int j = 0; j < 4; ++j) { v[j] = acc[ai][bj][m][0][j] * rs; v[4 + j] = acc[ai][bj][m][1][j] * rs; }
                    if (mode == 1) {
#pragma unroll
                        for (int e = 0; e < 8; ++e) v[e] = siluf_(v[e]);
                    } else if (mode == 3) {
                        const f32x4 l0 = *(const f32x4*)(lb + col - 2048), l1 = *(const f32x4*)(lb + col - 2048 + 4);
#pragma unroll
                        for (int e = 0; e < 8; ++e) { const float l = e < 4 ? l0[e & 3] : l1[e & 3]; const float f = l + (1.0f - l) * sigmoidf_(v[e]); v[e] = __logf(f); }
                    }
                    *(bf16x8*)(proj + (size_t)row * HG_NP + col) = pack8f(v);
                }
            }
    }
};
struct EpiOut {
    static constexpr bool PERM = false, AFTER_DRAIN = false;
    const float* xin; float* xout; bf16_t* xb; float* ssq;
    __device__ __forceinline__ void operator()(const f32x4 (&acc)[2][2][4][2], const pg8::Unit& u, int wr, int wc, int fr, int fq) const {
#pragma unroll
        for (int ai = 0; ai < 2; ++ai)
#pragma unroll
            for (int m = 0; m < 4; ++m) {
                const int row = u.pm * 256 + ai * 128 + wr * 64 + m * 16 + fr; float ss = 0.f;
#pragma unroll
                for (int bj = 0; bj < 2; ++bj)
#pragma unroll
                    for (int n = 0; n < 2; ++n) {
                        const size_t off = (size_t)row * DM + u.pn * 256 + bj * 128 + wc * 32 + n * 16 + 4 * fq;
                        const f32x4 xo = *(const f32x4*)(xin + off); const f32x4 xn = xo + acc[ai][bj][m][n];
                        *(f32x4*)(xout + off) = xn;
                        u32x2 w; w.x = cvt_pk_bf16(xn[0], xn[1]); w.y = cvt_pk_bf16(xn[2], xn[3]); *(u32x2*)(xb + off) = w;
                        ss += xn[0] * xn[0] + xn[1] * xn[1] + xn[2] * xn[2] + xn[3] * xn[3];
                    }
                ss += __shfl_xor(ss, 16); ss += __shfl_xor(ss, 32);
                if (fq == 0) atomicAdd(ssq + row, ss);
            }
    }
};
__device__ __forceinline__ void phase_prep(const Params& p, unsigned char* smem) {
    const int tid = get_tid(), lane = tid & 63, wave = tid >> 6, blk = blockIdx.x, nblk = gridDim.x;
    unsigned char* ws = p.ws;
    float* ssq = (float*)(ws + WS_SSQ); bf16_t* xb = (bf16_t*)(ws + WS_XB);
    for (int row = blk * 8 + wave; row < NTOK; row += nblk * 8) {
        const float* xr = p.x + (size_t)row * DM; float ss = 0.f;
#pragma unroll
        for (int i = 0; i < 4; ++i) {
            const int c = (i * 64 + lane) * 8; const f32x4 a = *(const f32x4*)(xr + c), b = *(const f32x4*)(xr + c + 4);
            ss += a[0] * a[0] + a[1] * a[1] + a[2] * a[2] + a[3] * a[3] + b[0] * b[0] + b[1] * b[1] + b[2] * b[2] + b[3] * b[3];
            *(bf16x8*)(xb + (size_t)row * DM + c) = pack44(a, b);
        }
#pragma unroll
        for (int o = 32; o >= 1; o >>= 1) ss += __shfl_xor(ss, o);
        if (lane == 0) ssq[row] = ss;
    }
    const int gtid = blk * NTHR + tid, gn = nblk * NTHR;
    for (int i = gtid; i < 4 * NTOK; i += gn) ssq[NTOK + i] = 0.f;
    float* rope = (float*)(ws + WS_ROPE);
    for (int i = gtid; i < NTOK * 16; i += gn) {
        const int t = i >> 4, f = i & 15;
        const float inv = powf(500000.0f, -(float)f / 16.0f);
        const float ang = (float)p.pos[t] * inv;
        double fr = (double)ang * 0.15915494309189533577; fr -= rint(fr);
        rope[t * 32 + f] = __builtin_amdgcn_cosf((float)fr); rope[t * 32 + 16 + f] = __builtin_amdgcn_sinf((float)fr);
    }
    float* lb = (float*)(ws + WS_LB);
    for (int i = gtid; i < 2048; i += gn) { const float a0 = p.hg_lb[i], a1 = p.hg_lb[2048 + i]; lb[i] = 0.f; lb[2048 + i] = 1.0f / (1.0f + __expf(a0 - a1)); }
    float* cb = (float*)(ws + WS_CBIAS);
    for (int it = blk * 8 + wave; it < 512; it += nblk * 8) {
        const int which = it >> 7, h = it & 127, layer = which >> 1;
        const float* pos = ((which & 1) ? p.cv_pos : p.ck_pos) + (size_t)layer * 4096;
        const float* w1 = ((which & 1) ? p.cv_w1 : p.ck_w1) + (size_t)layer * 4096 * 128;
        float s = 0.f;
        for (int k = lane; k < 4096; k += 64) s += pos[k] * w1[(size_t)k * 128 + h];
#pragma unroll
        for (int o = 32; o >= 1; o >>= 1) s += __shfl_xor(s, o);
        if (lane == 0) cb[which * 128 + h] = s;
    }
    float* tile = (float*)smem;
    for (int which = 0; which < 4; ++which) {
        const int layer = which >> 1;
        const float* w1 = ((which & 1) ? p.cv_w1 : p.ck_w1) + (size_t)layer * 4096 * 128;
        const float* w2 = ((which & 1) ? p.cv_w2 : p.ck_w2) + (size_t)layer * 128 * 128;
        tconv<0>(w1, 128, 128, (bf16_t*)(ws + WS_W1T) + (size_t)which * 128 * 4096, 4096, 128, nullptr, tile, blk, nblk);
        tconv<0>(w2, 128, 128, (bf16_t*)(ws + WS_W2T) + (size_t)which * 128 * 128, 128, 128, nullptr, tile, blk, nblk);
    }
    tconv<1>(p.nsa_w_in, NSA_IN, NSA_IN, (bf16_t*)(ws + WS_WIN), 2048, NSA_NP, p.norm_w, tile, blk, nblk);
}

__device__ __forceinline__ void compress_item(const Params& p, int nl, int item, unsigned char* smem) {
    const int tid = get_tid(), lane = tid & 63, w = tid >> 6, l15 = lane & 15, quad = lane >> 4;
    const int kv = item >> 7, bg = (item >> 4) & 7, nt = item & 15, b = bg >> 2, g = bg & 3, n0 = nt * 32;
    const int which = nl * 2 + kv;
    unsigned char* ws = p.ws;
    const bf16_t* proj = (const bf16_t*)(ws + WS_PROJ);
    const bf16_t* w1t = (const bf16_t*)(ws + WS_W1T) + (size_t)which * 128 * 4096;
    const bf16_t* w2t = (const bf16_t*)(ws + WS_W2T) + (size_t)which * 128 * 128;
    const float* cb = (const float*)(ws + WS_CBIAS) + which * 128;
    const int col0 = (kv ? VC0 : KC0) + g * 128;
    f32x4 acc[2] = {{0.f, 0.f, 0.f, 0.f}, {0.f, 0.f, 0.f, 0.f}};
    const bf16_t* brow = w1t + (size_t)(16 * w + l15) * 4096 + quad * 8;
    int tb[2];
#pragma unroll
    for (int rt = 0; rt < 2; ++rt) tb[rt] = 16 * (n0 + rt * 16 + l15);
#pragma unroll 4
    for (int ks = 0; ks < 128; ++ks) {
        const int l = ks >> 2, d = (ks & 3) * 32 + quad * 8;
        const bf16x8 bf = *(const bf16x8*)(brow + ks * 32);
#pragma unroll
        for (int rt = 0; rt < 2; ++rt) {
            int tok = tb[rt] + l; tok = tok > SEQ - 1 ? SEQ - 1 : tok;
            const bf16x8 af = *(const bf16x8*)(proj + (size_t)(b * SEQ + tok) * NSA_NP + col0 + d);
            acc[rt] = mfma16(af, bf, acc[rt]);
        }
    }
    bf16_t* sHid = (bf16_t*)smem;
    __syncthreads();
    { const float bias = cb[16 * w + l15];
#pragma unroll
      for (int rt = 0; rt < 2; ++rt)
#pragma unroll
          for (int j = 0; j < 4; ++j) sHid[(rt * 16 + quad * 4 + j) * 136 + 16 * w + l15] = f2bf(siluf_(acc[rt][j] + bias)); }
    __syncthreads();
    f32x4 oc[2] = {{0.f, 0.f, 0.f, 0.f}, {0.f, 0.f, 0.f, 0.f}};
#pragma unroll
    for (int kk = 0; kk < 4; ++kk) {
        const bf16x8 bf = *(const bf16x8*)(w2t + (size_t)(16 * w + l15) * 128 + kk * 32 + quad * 8);
#pragma unroll
        for (int rt = 0; rt < 2; ++rt) { const bf16x8 af = *(const bf16x8*)(sHid + (rt * 16 + l15) * 136 + kk * 32 + quad * 8); oc[rt] = mfma16(af, bf, oc[rt]); }
    }
    if (kv == 0) {
        bf16_t* kc = (bf16_t*)(ws + WS_KCMP) + (size_t)bg * 512 * 128;
#pragma unroll
        for (int rt = 0; rt < 2; ++rt)
#pragma unroll
            for (int j = 0; j < 4; ++j) { const int n = n0 + rt * 16 + quad * 4 + j; kc[(size_t)n * 128 + 16 * w + l15] = n < 511 ? f2bf(oc[rt][j]) : (bf16_t)0; }
    } else {
        bf16_t* vct = (bf16_t*)(ws + WS_VCMPT) + (size_t)bg * 128 * 512;
#pragma unroll
        for (int rt = 0; rt < 2; ++rt) {
            const int n = n0 + rt * 16 + quad * 4; f32x4 v = oc[rt]; if (n + 3 >= 511) v[3] = 0.f;
            u32x2 wv; wv.x = cvt_pk_bf16(v[0], v[1]); wv.y = cvt_pk_bf16(v[2], v[3]);
            *(u32x2*)(vct + (size_t)(16 * w + l15) * 512 + n) = wv;
        }
    }
    __syncthreads();
}
__device__ __forceinline__ void vtrans_item(const Params& p, int item, unsigned char* smem) {
    const int tid = get_tid(); const int which = item >> 10, bg = (item >> 7) & 7, tt = item & 127, b = bg >> 2, g = bg & 3, s0 = tt * 64;
    const bf16_t* proj = (const bf16_t*)(p.ws + WS_PROJ);
    bf16_t* dst = (bf16_t*)(p.ws + (which ? WS_VWT : WS_VST)) + (size_t)bg * 128 * SEQ;
    const int col0 = (which ? VW0 : VS0) + g * 128;
    bf16_t* t = (bf16_t*)smem;
    __syncthreads();
#pragma unroll
    for (int i = 0; i < 2; ++i) { const int c = tid + 512 * i, r = c >> 4, c8 = (c & 15) * 8;
        *(bf16x8*)(t + r * 136 + c8) = *(const bf16x8*)(proj + (size_t)(b * SEQ + s0 + r) * NSA_NP + col0 + c8); }
    __syncthreads();
    { const int d = tid >> 2, k16 = (tid & 3) * 16; bf16x8 o0, o1;
#pragma unroll
      for (int j = 0; j < 8; ++j) { o0[j] = (short)t[(k16 + j) * 136 + d]; o1[j] = (short)t[(k16 + 8 + j) * 136 + d]; }
      *(bf16x8*)(dst + (size_t)d * SEQ + s0 + k16) = o0; *(bf16x8*)(dst + (size_t)d * SEQ + s0 + k16 + 8) = o1; }
}
#ifndef ATT_SKIP
#define ATT_SKIP 0
#endif
constexpr int SKP = 136, SVP = 72;
constexpr int A_SK = 0, A_SV = 17408, A_IA = 35840, A_IE = 52224, A_IMP = 68608, A_SEL = 102400;
constexpr float ATT_C2 = 0.08838834764831845f * 1.4426950408889634f;

template <int MODE>
__device__ __forceinline__ void attn_branch(const bf16_t* __restrict__ kbase, int kpitch, const bf16_t* __restrict__ vtbase, int vlen, int t_lo, int t_hi,
                                            const bf16x8 (&qf)[2][4], const int (&tq)[2], float (&mrow)[2], float (&lrow)[2], f32x4 (&o)[2][8],
                                            const unsigned long long (&selm)[2][2], unsigned char* smem) {
    const int tid = get_tid(), lane = tid & 63, w = tid >> 6, l15 = lane & 15, quad = lane >> 4;
    bf16_t* sK = (bf16_t*)(smem + A_SK); bf16_t* sVt = (bf16_t*)(smem + A_SV);
    float* sIA = (float*)(smem + A_IA); float* sIE = (float*)(smem + A_IE); float* sImp = (float*)(smem + A_IMP);
    const float NEG_INF = -__builtin_inff();
    bf16x8 kreg[2], vreg[2];
    const int krow = tid >> 4, kc8 = (tid & 15) * 8, vd = tid >> 3, vk8 = (tid & 7) * 8;
    if (t_lo < t_hi) {
#pragma unroll
        for (int i = 0; i < 2; ++i) {
            kreg[i] = *(const bf16x8*)(kbase + (size_t)(t_lo * 64 + krow + 32 * i) * kpitch + kc8);
            if (MODE != 0) vreg[i] = *(const bf16x8*)(vtbase + (size_t)(vd + 64 * i) * vlen + t_lo * 64 + vk8);
        }
    }
    float il1[2] = {0.f, 0.f};
    if (MODE == 1) {
#pragma unroll
        for (int qt = 0; qt < 2; ++qt) il1[qt] = lrow[qt] > 0.f ? 1.0f / lrow[qt] : 0.f;
    }
    for (int t = t_lo; t < t_hi; ++t) {
        __syncthreads();
#pragma unroll
        for (int i = 0; i < 2; ++i) {
            *(bf16x8*)(sK + (krow + 32 * i) * SKP + kc8) = kreg[i];
            if (MODE != 0) *(bf16x8*)(sVt + (vd + 64 * i) * SVP + vk8) = vreg[i];
        }
        __syncthreads();
        if (t + 1 < t_hi) {
#pragma unroll
            for (int i = 0; i < 2; ++i) {
                kreg[i] = *(const bf16x8*)(kbase + (size_t)((t + 1) * 64 + krow + 32 * i) * kpitch + kc8);
                if (MODE != 0) vreg[i] = *(const bf16x8*)(vtbase + (size_t)(vd + 64 * i) * vlen + (t + 1) * 64 + vk8);
            }
        }
        const int key0 = t * 64;
        bool rowsel[2] = {true, true}; bool active = true;
        if (MODE == 3) {
#pragma unroll
            for (int qt = 0; qt < 2; ++qt) rowsel[qt] = ((((t < 64) ? selm[qt][0] : selm[qt][1]) >> (t & 63)) & 1ull) != 0ull;
            active = __any((int)(rowsel[0] || rowsel[1])) != 0;
        }
        if (active) {
            f32x4 st[2][4];
#pragma unroll
            for (int qt = 0; qt < 2; ++qt)
#pragma unroll
                for (int kt = 0; kt < 4; ++kt) st[qt][kt] = (f32x4){0.f, 0.f, 0.f, 0.f};
#pragma unroll
            for (int kt = 0; kt < 4; ++kt)
#pragma unroll
                for (int kk = 0; kk < 4; ++kk) {
                    const bf16x8 a = *(const bf16x8*)(sK + (kt * 16 + l15) * SKP + kk * 32 + quad * 8);
                    st[0][kt] = mfma16(a, qf[0][kk], st[0][kt]);
                    st[1][kt] = mfma16(a, qf[1][kk], st[1][kt]);
                }
            bf16x8 pf[2][2];
#pragma unroll
            for (int qt = 0; qt < 2; ++qt) {
                const int tpos = tq[qt];
                float x[4][4]; float mx = -1e30f; unsigned vmask = 0u;
#pragma unroll
                for (int kt = 0; kt < 4; ++kt)
#pragma unroll
                    for (int j = 0; j < 4; ++j) {
                        const int key = key0 + kt * 16 + quad * 4 + j; bool vis;
                        if (MODE <= 1) vis = (16 * key + 31 <= tpos);
                        else if (MODE == 2) vis = (key <= tpos) && (key > tpos - 512);
                        else vis = rowsel[qt] && (key <= tpos);
                        x[kt][j] = vis ? st[qt][kt][j] * ATT_C2 : -1e30f; vmask |= vis ? (1u << (kt * 4 + j)) : 0u;
                        mx = fmaxf(mx, x[kt][j]);
                    }
                if (MODE == 1) {
                    const float m = mrow[qt], il = il1[qt];
                    const int tl = (w & 1) * 32 + qt * 16 + l15, r = w >> 1;
#pragma unroll
                    for (int kt = 0; kt < 4; ++kt) {
#pragma unroll
                        for (int j = 0; j < 4; ++j) x[kt][j] = ((vmask >> (kt * 4 + j)) & 1u) ? __builtin_amdgcn_exp2f(fmaxf(x[kt][j] - m, -120.f)) * il : 0.f;
                        sIA[(r * 64 + tl) * 16 + kt * 4 + quad] = (x[kt][0] + x[kt][1]) + (x[kt][2] + x[kt][3]);
                        sIE[(r * 64 + tl) * 16 + kt * 4 + quad] = x[kt][3];
                    }
                } else {
                    mx = fmaxf(mx, __shfl_xor(mx, 16)); mx = fmaxf(mx, __shfl_xor(mx, 32));
                    const float mn = fmaxf(mrow[qt], mx);
                    const float alpha = __builtin_amdgcn_exp2f(fmaxf(mrow[qt] - mn, -120.f)); mrow[qt] = mn;
                    float rs = 0.f;
#pragma unroll
                    for (int kt = 0; kt < 4; ++kt)
#pragma unroll
                        for (int j = 0; j < 4; ++j) { x[kt][j] = ((vmask >> (kt * 4 + j)) & 1u) ? __builtin_amdgcn_exp2f(fmaxf(x[kt][j] - mn, -120.f)) : 0.f; rs += x[kt][j]; }
                    rs += __shfl_xor(rs, 16); rs += __shfl_xor(rs, 32);
                    lrow[qt] = lrow[qt] * alpha + rs;
                    if (MODE != 0) {
#pragma unroll
                        for (int dt = 0; dt < 8; ++dt) o[qt][dt] = o[qt][dt] * alpha;
                    }
                }
                if (MODE != 0) {
#pragma unroll
                    for (int ks = 0; ks < 2; ++ks) {
                        u32x4 wv = {cvt_pk_bf16(x[2 * ks][0], x[2 * ks][1]), cvt_pk_bf16(x[2 * ks][2], x[2 * ks][3]), cvt_pk_bf16(x[2 * ks + 1][0], x[2 * ks + 1][1]), cvt_pk_bf16(x[2 * ks + 1][2], x[2 * ks + 1][3])};
                        pf[qt][ks] = *reinterpret_cast<bf16x8*>(&wv);
                    }
                }
            }
            if (MODE != 0) {
#pragma unroll
                for (int dt = 0; dt < 8; ++dt)
#pragma unroll
                    for (int ks = 0; ks < 2; ++ks) {
                        const bf16_t* vp = sVt + (dt * 16 + l15) * SVP + ks * 32 + quad * 4;
                        const bf16x4 lo = *(const bf16x4*)vp, hi = *(const bf16x4*)(vp + 16);
                        const bf16x8 a = {lo[0], lo[1], lo[2], lo[3], hi[0], hi[1], hi[2], hi[3]};
                        o[0][dt] = mfma16(a, pf[0][ks], o[0][dt]);
                        o[1][dt] = mfma16(a, pf[1][ks], o[1][dt]);
                    }
            }
        }
        if (MODE == 1) {
            __syncthreads();
#pragma unroll
            for (int i = 0; i < 2; ++i) {
                const int pidx = tid + 512 * i, tl = pidx >> 4, kq = pidx & 15;
                float a = 0.f, e = 0.f, e15 = 0.f;
#pragma unroll
                for (int r = 0; r < 4; ++r) { a += sIA[(r * 64 + tl) * 16 + kq]; if (kq > 0) e += sIE[(r * 64 + tl) * 16 + kq - 1]; if (kq == 15) e15 += sIE[(r * 64 + tl) * 16 + 15]; }
                sImp[tl * 132 + key0 / 4 + kq] += a + e;
                if (kq == 15) sImp[tl * 132 + key0 / 4 + 16] += e15;
            }
        }
    }
}

template <int BR>
__device__ __forceinline__ void attn_merge(const f32x4 (&o)[2][8], const float (&lrow)[2], bool normalised, const bf16_t* __restrict__ proj, bf16_t* __restrict__ obuf, int gate_col, int b, int head, const int (&tq)[2], int quad) {
#pragma unroll
    for (int qt = 0; qt < 2; ++qt) {
        const size_t trow = (size_t)(b * SEQ + tq[qt]);
        const float gate = bf2f(proj[trow * NSA_NP + gate_col]);
        const float f = gate * (normalised ? 1.0f : (lrow[qt] > 0.f ? 1.0f / lrow[qt] : 0.f));
#pragma unroll
        for (int dt = 0; dt < 8; ++dt) {
            bf16_t* op = obuf + trow * DM + head * 128 + dt * 16 + quad * 4;
            f32x4 v = o[qt][dt] * f;
            if (BR != 0) { const u32x2 old = *(const u32x2*)op; v[0] += bflo(old.x); v[1] += bfhi(old.x); v[2] += bflo(old.y); v[3] += bfhi(old.y); }
            if (BR == 2) { const u32x2 z = *(const u32x2*)(proj + trow * NSA_NP + Z0 + head * 128 + dt * 16 + quad * 4); v[0] *= bflo(z.x); v[1] *= bfhi(z.x); v[2] *= bflo(z.y); v[3] *= bfhi(z.y); }
            u32x2 wv; wv.x = cvt_pk_bf16(v[0], v[1]); wv.y = cvt_pk_bf16(v[2], v[3]); *(u32x2*)op = wv;
        }
    }
}

__device__ __forceinline__ void attn_item(const Params& p, int bg, int qi, unsigned char* smem) {
    const int tid = get_tid(), lane = tid & 63, w = tid >> 6, l15 = lane & 15, quad = lane >> 4;
    const int b = bg >> 2, g = bg & 3, s0 = qi * 64, r = w >> 1, head = g * 4 + r, tok0 = s0 + (w & 1) * 32, cur = qi;
    unsigned char* ws = p.ws;
    const bf16_t* proj = (const bf16_t*)(ws + WS_PROJ); bf16_t* obuf = (bf16_t*)(ws + WS_OBUF);
    float* sImp = (float*)(smem + A_IMP); float* sScore = (float*)(smem + A_IA); unsigned long long* sSel = (unsigned long long*)(smem + A_SEL);
    const int tq[2] = {tok0 + l15, tok0 + 16 + l15};
    bf16x8 qf[2][4];
#pragma unroll
    for (int qt = 0; qt < 2; ++qt)
#pragma unroll
        for (int kk = 0; kk < 4; ++kk) qf[qt][kk] = *(const bf16x8*)(proj + (size_t)(b * SEQ + tq[qt]) * NSA_NP + Q0 + head * 128 + kk * 32 + quad * 8);
    __syncthreads();
    for (int i = tid; i < 64 * 132; i += NTHR) sImp[i] = 0.f;
    float mrow[2], lrow[2]; f32x4 o[2][8];
    unsigned long long selm[2][2] = {{0ull, 0ull}, {0ull, 0ull}};
    const bf16_t* projb = proj + (size_t)b * SEQ * NSA_NP;
    {
        const bf16_t* kc = (const bf16_t*)(ws + WS_KCMP) + (size_t)bg * 512 * 128; const bf16_t* vct = (const bf16_t*)(ws + WS_VCMPT) + (size_t)bg * 128 * 512;
        const int nmax = (s0 + 32) / 16, nt = nmax / 64 + 1;
        mrow[0] = mrow[1] = -1e30f; lrow[0] = lrow[1] = 0.f;
#pragma unroll
        for (int qt = 0; qt < 2; ++qt)
#pragma unroll
            for (int dt = 0; dt < 8; ++dt) o[qt][dt] = (f32x4){0.f, 0.f, 0.f, 0.f};
#if !(ATT_SKIP & 1)
        attn_branch<0>(kc, 128, vct, 512, 0, nt, qf, tq, mrow, lrow, o, selm, smem);
        attn_branch<1>(kc, 128, vct, 512, 0, nt, qf, tq, mrow, lrow, o, selm, smem);
#endif
        attn_merge<0>(o, lrow, true, proj, obuf, GL0 + 0 * 16 + head, b, head, tq, quad);
    }
    __syncthreads();
#pragma unroll 1
    for (int i = 0; i < 16; ++i) {
        const int pidx = tid + 512 * i, tl = pidx >> 7, k = pidx & 127;
        const float v = sImp[tl * 132 + k];
        const bool valid = k <= cur, forced = (k == 0) || (k == cur) || (k == cur - 1);
        sScore[pidx] = valid ? (forced ? 1e30f : v) : -1e30f;
    }
    __syncthreads();
#pragma unroll 1
    for (int i = 0; i < 16; ++i) {
        const int pidx = tid + 512 * i, tl = pidx >> 7, k = pidx & 127;
        const float sc = sScore[pidx]; int rank = 0;
#pragma unroll 4
        for (int k2 = 0; k2 < 128; k2 += 4) {
            const f32x4 s4 = *(const f32x4*)(sScore + tl * 128 + k2);
#pragma unroll
            for (int j = 0; j < 4; ++j) rank += ((s4[j] > sc) || (s4[j] == sc && (k2 + j) < k)) ? 1 : 0;
        }
        const unsigned long long bal = __ballot(rank < 16);
        if (lane == 0) sSel[tl * 2 + (k >> 6)] = bal;
    }
    __syncthreads();
#pragma unroll
    for (int qt = 0; qt < 2; ++qt) { const int tl = (w & 1) * 32 + qt * 16 + l15; selm[qt][0] = sSel[tl * 2]; selm[qt][1] = sSel[tl * 2 + 1]; }
    {
        mrow[0] = mrow[1] = -1e30f; lrow[0] = lrow[1] = 0.f;
#pragma unroll
        for (int qt = 0; qt < 2; ++qt)
#pragma unroll
            for (int dt = 0; dt < 8; ++dt) o[qt][dt] = (f32x4){0.f, 0.f, 0.f, 0.f};
        const int t_lo = qi - 8 > 0 ? qi - 8 : 0;
#if !(ATT_SKIP & 2)
        attn_branch<2>(projb + KW0 + g * 128, NSA_NP, (const bf16_t*)(ws + WS_VWT) + (size_t)bg * 128 * SEQ, SEQ, t_lo, qi + 1, qf, tq, mrow, lrow, o, selm, smem);
#endif
        attn_merge<1>(o, lrow, false, proj, obuf, GL0 + 2 * 16 + head, b, head, tq, quad);
    }
    {
        mrow[0] = mrow[1] = -1e30f; lrow[0] = lrow[1] = 0.f;
#pragma unroll
        for (int qt = 0; qt < 2; ++qt)
#pragma unroll
            for (int dt = 0; dt < 8; ++dt) o[qt][dt] = (f32x4){0.f, 0.f, 0.f, 0.f};
#if !(ATT_SKIP & 4)
        attn_branch<3>(projb + KS0 + g * 128, NSA_NP, (const bf16_t*)(ws + WS_VST) + (size_t)bg * 128 * SEQ, SEQ, 0, cur + 1, qf, tq, mrow, lrow, o, selm, smem);
#endif
        attn_merge<2>(o, lrow, false, proj, obuf, GL0 + 1 * 16 + head, b, head, tq, quad);
    }
    __syncthreads();
}
constexpr int H_G = 0;
constexpr int H_TOT = 16384;
constexpr int H_DEC = 18432;
constexpr int H_QB = 18944;
constexpr int H_KM = 27648;
constexpr int H_KBT = 36352;
constexpr int H_IT = 46592;
constexpr int H_ATT = 56832;
constexpr int H_O = 59392;
template <int PASS>
__device__ __forceinline__ void hgrn_item(const Params& p, int hl, int item, unsigned char* smem) {
    const int tid = get_tid(), lane = tid & 63, w = tid >> 6, l15 = lane & 15, quad = lane >> 4;
    const int bh = item >> 3, seg = item & 7, b = bh >> 4, h = bh & 15;
    unsigned char* ws = p.ws;
    const bf16_t* proj = (const bf16_t*)(ws + WS_PROJ); bf16_t* obuf = (bf16_t*)(ws + WS_OBUF);
    float* hseg = (float*)(ws + WS_HSEG);
    float* sTot = (float*)(smem + H_TOT); float* sDec = (float*)(smem + H_DEC);
    bf16_t* sQb = (bf16_t*)(smem + H_QB); bf16_t* sKm = (bf16_t*)(smem + H_KM); bf16_t* sKbT = (bf16_t*)(smem + H_KBT); bf16_t* sIT = (bf16_t*)(smem + H_IT);
    bf16_t* sAtt = (bf16_t*)(smem + H_ATT); float* sO = (float*)(smem + H_O);
    const int d = tid & 127, tqr = tid >> 7;
    const size_t tokbase = (size_t)b * SEQ + (size_t)seg * 1024;
    const bf16_t* pq = proj + tokbase * HG_NP + h * 128 + d;
    f32x4 S[8];
#pragma unroll
    for (int dt = 0; dt < 8; ++dt) S[dt] = (f32x4){0.f, 0.f, 0.f, 0.f};
    if (PASS == 1) {
        for (int sj = 0; sj < seg; ++sj) {
            const float* U = hseg + (size_t)(bh * 8 + sj) * HSEG_STRIDE; const float* Dv = U + 128 * 128;
#pragma unroll
            for (int dt = 0; dt < 8; ++dt)
#pragma unroll
                for (int j = 0; j < 4; ++j) { const int dd = dt * 16 + quad * 4 + j; S[dt][j] = S[dt][j] * Dv[dd] + U[dd * 128 + 16 * w + l15]; }
        }
    }
    float gtot = 0.f;
    const float gw = p.hg_gn[hl * 128 + (tid & 15) * 8 + 0];
    (void)gw;
    for (int c = 0; c < 32; ++c) {
        const bf16_t* pc = pq + (size_t)(c * 32 + tqr * 8) * HG_NP;
        float g8[8], q8[8], i8[8];
#pragma unroll
        for (int j = 0; j < 8; ++j) {
            g8[j] = bf2f(pc[(size_t)j * HG_NP + 2048]);
            i8[j] = bf2f(pc[(size_t)j * HG_NP + 4096]);
            if (PASS == 1) q8[j] = bf2f(pc[(size_t)j * HG_NP]);
        }
        float cs[8]; cs[0] = g8[0];
#pragma unroll
        for (int j = 1; j < 8; ++j) cs[j] = cs[j - 1] + g8[j];
        sTot[tqr * 128 + d] = cs[7];
        __syncthreads();
        float off = 0.f, bl = 0.f;
#pragma unroll
        for (int q = 0; q < 4; ++q) { const float tv = sTot[q * 128 + d]; bl += tv; if (q < tqr) off += tv; }
        { float kb[8], iv[8];
#pragma unroll
          for (int j = 0; j < 8; ++j) {
              const float bt = off + cs[j];
              const float kk = 1.0f - __expf(g8[j]);
              kb[j] = kk * __expf(bl - bt); iv[j] = i8[j];
              if (PASS == 1) {
                  const int t = tqr * 8 + j;
                  sQb[t * 136 + d] = f2bf(q8[j] * __expf(bt));
                  sKm[t * 136 + d] = f2bf(kk * __expf(fminf(-bt, 80.f)));
              }
          }
          *(bf16x8*)(sKbT + d * 40 + tqr * 8) = pack8f(kb);
          *(bf16x8*)(sIT + d * 40 + tqr * 8) = pack8f(iv); }
        if (tqr == 0) { sDec[d] = __expf(bl); gtot += bl; }
        __syncthreads();
        const bf16x8 ifr = *(const bf16x8*)(sIT + (16 * w + l15) * 40 + quad * 8);
        f32x4 oacc[2] = {{0.f, 0.f, 0.f, 0.f}, {0.f, 0.f, 0.f, 0.f}};
        if (PASS == 1) {
            if (w < 4) {
                const int rt = w >> 1, ct = w & 1; f32x4 a4 = {0.f, 0.f, 0.f, 0.f};
#pragma unroll
                for (int kk = 0; kk < 4; ++kk) {
                    const bf16x8 a = *(const bf16x8*)(sQb + (rt * 16 + l15) * 136 + kk * 32 + quad * 8);
                    const bf16x8 bb = *(const bf16x8*)(sKm + (ct * 16 + l15) * 136 + kk * 32 + quad * 8);
                    a4 = mfma16(a, bb, a4);
                }
#pragma unroll
                for (int j = 0; j < 4; ++j) { const int t = rt * 16 + quad * 4 + j, s = ct * 16 + l15; sAtt[t * 40 + s] = f2bf(s <= t ? a4[j] : 0.f); }
            }
#pragma unroll
            for (int kk = 0; kk < 4; ++kk) {
                const bf16x8 bs = pack44(S[2 * kk], S[2 * kk + 1]);
#pragma unroll
                for (int rt = 0; rt < 2; ++rt) {
                    const bf16_t* qp = sQb + (rt * 16 + l15) * 136 + kk * 32 + quad * 4;
                    const bf16x4 lo = *(const bf16x4*)qp, hi = *(const bf16x4*)(qp + 16);
                    const bf16x8 a = {lo[0], lo[1], lo[2], lo[3], hi[0], hi[1], hi[2], hi[3]};
                    oacc[rt] = mfma16(a, bs, oacc[rt]);
                }
            }
        }
#pragma unroll
        for (int dt = 0; dt < 8; ++dt) {
            const f32x4 dc = *(const f32x4*)(sDec + dt * 16 + quad * 4);
            const bf16x8 a = *(const bf16x8*)(sKbT + (dt * 16 + l15) * 40 + quad * 8);
            S[dt] = mfma16(a, ifr, S[dt] * dc);
        }
        if (PASS == 1) {
            __syncthreads();
#pragma unroll
            for (int rt = 0; rt < 2; ++rt) { const bf16x8 a = *(const bf16x8*)(sAtt + (rt * 16 + l15) * 40 + quad * 8); oacc[rt] = mfma16(a, ifr, oacc[rt]); }
#pragma unroll
            for (int rt = 0; rt < 2; ++rt)
#pragma unroll
                for (int j = 0; j < 4; ++j) sO[(rt * 16 + quad * 4 + j) * 132 + 16 * w + l15] = oacc[rt][j];
            __syncthreads();
            { const int t = tid >> 4, i8c = (tid & 15) * 8; float v[8]; float ss = 0.f;
              const f32x4 a0 = *(const f32x4*)(sO + t * 132 + i8c), a1 = *(const f32x4*)(sO + t * 132 + i8c + 4);
#pragma unroll
              for (int j = 0; j < 4; ++j) { v[j] = a0[j]; v[4 + j] = a1[j]; }
#pragma unroll
              for (int j = 0; j < 8; ++j) ss += v[j] * v[j];
              ss += __shfl_xor(ss, 1); ss += __shfl_xor(ss, 2); ss += __shfl_xor(ss, 4); ss += __shfl_xor(ss, 8);
              const float rinv = rsqrtf(ss * (1.0f / 128.0f) + RMS_EPS);
              const size_t tok = tokbase + c * 32 + t;
              const u32x4 z = *(const u32x4*)(proj + tok * HG_NP + 6144 + h * 128 + i8c);
              const float* gwp = p.hg_gn + hl * 128 + i8c; const f32x4 g0 = *(const f32x4*)gwp, g1 = *(const f32x4*)(gwp + 4);
              v[0] *= rinv * g0[0] * bflo(z.x); v[1] *= rinv * g0[1] * bfhi(z.x); v[2] *= rinv * g0[2] * bflo(z.y); v[3] *= rinv * g0[3] * bfhi(z.y);
              v[4] *= rinv * g1[0] * bflo(z.z); v[5] *= rinv * g1[1] * bfhi(z.z); v[6] *= rinv * g1[2] * bflo(z.w); v[7] *= rinv * g1[3] * bfhi(z.w);
              *(bf16x8*)(obuf + tok * DM + h * 128 + i8c) = pack8f(v); }
        }
    }
    if (PASS == 0) {
        float* U = hseg + (size_t)(bh * 8 + seg) * HSEG_STRIDE;
#pragma unroll
        for (int dt = 0; dt < 8; ++dt)
#pragma unroll
            for (int j = 0; j < 4; ++j) U[(dt * 16 + quad * 4 + j) * 128 + 16 * w + l15] = S[dt][j];
        if (tqr == 0) U[128 * 128 + d] = __expf(gtot);
    }
    __syncthreads();
}

#ifndef DEBUG_CENSUS
#define DEBUG_CENSUS 0
#endif
#if DEBUG_CENSUS
__device__ __forceinline__ void scan_bf16(const bf16_t* ptr, size_t n, int code, int* flag) {
    bool bad = false; const size_t st = (size_t)gridDim.x * NTHR;
    for (size_t i = (size_t)blockIdx.x * NTHR + get_tid(); i < n; i += st) bad |= ((ptr[i] & 0x7f80) == 0x7f80);
    if (bad) atomicMin(flag, code);
}
__device__ __forceinline__ void scan_f32(const float* ptr, size_t n, int code, int* flag) {
    bool bad = false; const size_t st = (size_t)gridDim.x * NTHR;
    for (size_t i = (size_t)blockIdx.x * NTHR + get_tid(); i < n; i += st) bad |= ((__float_as_uint(ptr[i]) & 0x7f800000u) == 0x7f800000u);
    if (bad) atomicMin(flag, code);
}
__device__ __noinline__ void census_unused(); __device__ __forceinline__ void census(const Params& p, int ph) {
    unsigned char* ws = p.ws; int* flag = (int*)(ws + WS_CBIAS + 2048);
    const int layer = (ph - 1) >> 2, sub = (ph - 1) & 3; const bool nsa = (layer & 1) == 0;
    if (ph == 0) { scan_bf16((bf16_t*)(ws + WS_XB), (size_t)NTOK * DM, 0, flag); scan_bf16((bf16_t*)(ws + WS_WIN), (size_t)NSA_NP * DM, 1, flag);
        scan_f32((float*)(ws + WS_ROPE), (size_t)NTOK * 32, 2, flag); scan_f32((float*)(ws + WS_CBIAS), 512, 3, flag); scan_f32((float*)(ws + WS_LB), 4096, 4, flag); scan_f32((float*)(ws + WS_SSQ), NTOK, 5, flag);
        scan_bf16((bf16_t*)(ws + WS_W1T), (size_t)4 * 128 * 4096, 6, flag); scan_bf16((bf16_t*)(ws + WS_W2T), (size_t)4 * 128 * 128, 7, flag); }
    else if (ph == 17) {}
    else if (sub == 0) scan_bf16((bf16_t*)(ws + WS_PROJ), (size_t)NTOK * (nsa ? NSA_NP : HG_NP), 8 + 8 * layer + 0, flag);
    else if (sub == 1) { if (nsa) { scan_bf16((bf16_t*)(ws + WS_KCMP), (size_t)8 * 512 * 128, 8 + 8 * layer + 1, flag); scan_bf16((bf16_t*)(ws + WS_VCMPT), (size_t)8 * 512 * 128, 8 + 8 * layer + 2, flag);
                                   scan_bf16((bf16_t*)(ws + WS_VST), (size_t)8 * 128 * SEQ, 8 + 8 * layer + 3, flag); scan_bf16((bf16_t*)(ws + WS_VWT), (size_t)8 * 128 * SEQ, 8 + 8 * layer + 3, flag); }
                         else { for (int it = 0; it < 256; ++it) if ((it & 7) != 7) scan_f32((float*)(ws + WS_HSEG) + (size_t)it * HSEG_STRIDE, HSEG_STRIDE, 8 + 8 * layer + 1, flag); }
                         scan_bf16((bf16_t*)(ws + WS_WOUT), (size_t)DM * DM, 8 + 8 * layer + 4, flag); scan_bf16((bf16_t*)(ws + WS_WIN), (size_t)DM * NSA_NP, 8 + 8 * layer + 4, flag); }
    else if (sub == 2) scan_bf16((bf16_t*)(ws + WS_OBUF), (size_t)NTOK * DM, 8 + 8 * layer + 5, flag);
    else { scan_f32(p.out, (size_t)NTOK * DM, 8 + 8 * layer + 6, flag); scan_f32((float*)(ws + WS_SSQ) + (size_t)(layer + 1) * NTOK, NTOK, 8 + 8 * layer + 7, flag); }
}
#endif
constexpr int N_PHASES = 18;
__global__ void __launch_bounds__(NTHR, 2) fwd_kernel(Params p_in) {
    extern __shared__ __attribute__((aligned(16))) unsigned char smem[];
    const int tid = get_tid();
    float* tile = (float*)smem;
    const Params& p0 = p_in;
    for (int ph = p0.ph_lo; ph < p0.ph_hi; ++ph) {
        Params p = p0;
        unsigned char* ws = p.ws; int blk = blockIdx.x, nblk = gridDim.x;
        asm volatile("" : "+s"(ws), "+s"(blk), "+s"(nblk));
        p.ws = ws;
        bf16_t* Win = (bf16_t*)(ws + WS_WIN); bf16_t* Wout = (bf16_t*)(ws + WS_WOUT);
        bf16_t* xb = (bf16_t*)(ws + WS_XB); bf16_t* proj = (bf16_t*)(ws + WS_PROJ); bf16_t* obuf = (bf16_t*)(ws + WS_OBUF);
        float* ssq = (float*)(ws + WS_SSQ);
        if (ph == 0) phase_prep(p, smem);
#if DEBUG_CENSUS
        else if (ph == 17) { const size_t st = (size_t)nblk * NTHR; for (size_t i = (size_t)blk * NTHR + tid; i < (size_t)NTOK * DM; i += st) p.out[i] = 0.f;
            if (blk == 0 && tid == 0) { int c = *(int*)(ws + WS_CBIAS + 2048); if (c > 80) c = 80; p.out[0] = (10.f + (float)c) * 1000.f; } }
#endif
        else if (ph == 17) {
            const int lane = tid & 63, wave = tid >> 6;
            for (int row = blk * 8 + wave; row < NTOK; row += nblk * 8) {
                const float rs = rsqrtf(ssq[4 * NTOK + row] * (1.0f / 2048.0f) + RMS_EPS); float* xr = p.out + (size_t)row * DM;
#pragma unroll
                for (int i = 0; i < 8; ++i) { const int c = (i * 64 + lane) * 4; f32x4 v = *(const f32x4*)(xr + c); const f32x4 wv = *(const f32x4*)(p.fnorm_w + c); v = v * rs * wv;
#if SANITIZE
                    for (int e = 0; e < 4; ++e) if (!(fabsf(v[e]) < 1e30f)) v[e] = 0.f;
#endif
                    *(f32x4*)(xr + c) = v; }
            }
        } else {
            const int layer = (ph - 1) >> 2, sub = (ph - 1) & 3, j = layer >> 1; const bool nsa = (layer & 1) == 0;
            if (sub == 0) {
                if (nsa) { pg8::Gemm g{xb, Win, NTOK, NSA_NP, DM}; pg8::StaticOrder S; S.init(NTOK, NSA_NP, nblk, blk);
                    EpiNsaIn E{proj, ssq + (size_t)layer * NTOK, (const float*)(ws + WS_ROPE)};
                    pg8::gemm_phase<EpiNsaIn, pg8::StaticOrder, false>((PG8_LAS unsigned char*)smem, g, S, E, nullptr); }
                else { pg8::Gemm g{xb, Win, NTOK, HG_NP, DM}; pg8::StaticOrder S; S.init(NTOK, HG_NP, nblk, blk);
                    EpiHgIn E{proj, ssq + (size_t)layer * NTOK, (const float*)(ws + WS_LB) + j * 2048};
                    pg8::gemm_phase<EpiHgIn, pg8::StaticOrder, false>((PG8_LAS unsigned char*)smem, g, S, E, nullptr); }
            } else if (sub == 1) {
                if (nsa) {
                    for (int it = blk; it < 256; it += nblk) compress_item(p, j, it, smem);
                    for (int it = blk; it < 2048; it += nblk) vtrans_item(p, it, smem);
                    tconv<0>(p.nsa_w_out + (size_t)j * DM * DM, DM, DM, Wout, DM, DM, nullptr, tile, blk, nblk);
                    tconv<0>(p.hg_w_in + (size_t)j * DM * HG_NP, HG_NP, HG_NP, Win, DM, HG_NP, p.norm_w + (size_t)(layer + 1) * DM, tile, blk, nblk);
                } else {
                    for (int it = blk; it < 256; it += nblk) if ((it & 7) != 7) hgrn_item<0>(p, j, it, smem);
                    tconv<0>(p.hg_w_out + (size_t)j * DM * DM, DM, DM, Wout, DM, DM, nullptr, tile, blk, nblk);
                    if (layer + 1 < 4) tconv<1>(p.nsa_w_in + (size_t)(j + 1) * DM * NSA_IN, NSA_IN, NSA_IN, Win, DM, NSA_NP, p.norm_w + (size_t)(layer + 1) * DM, tile, blk, nblk);
                }
            } else if (sub == 2) {
                if (nsa) {
                    for (int it = blk; it < 1024; it += nblk) { const int slot = it & 255, rnd = it >> 8, bg = slot >> 5, jj = slot & 31;
                        const int qi = rnd == 0 ? 127 - jj : (rnd == 1 ? 64 + jj : (rnd == 2 ? 63 - jj : jj));
                        attn_item(p, bg, qi, smem); }
                } else {
                    for (int it = blk; it < 256; it += nblk) hgrn_item<1>(p, j, it, smem);
                }
            } else {
                pg8::Gemm g{obuf, Wout, NTOK, DM, DM}; pg8::StaticOrder S; S.init(NTOK, DM, nblk, blk);
                EpiOut E{layer == 0 ? p.x : (const float*)p.out, p.out, xb, ssq + (size_t)(layer + 1) * NTOK};
                pg8::gemm_phase<EpiOut, pg8::StaticOrder, false>((PG8_LAS unsigned char*)smem, g, S, E, nullptr);
            }
        }
#if DEBUG_CENSUS
        if (ph != 17) census(p, ph);
#endif
        if (ph + 1 < p0.ph_hi) { if (p0.coop) { cg::this_grid().sync(); } }
    }
}

extern "C" void kernel_launch(void* const* d_in, const int* in_sizes, int n_in, void* d_out, int out_size, void* d_ws, size_t ws_size, hipStream_t stream) {
    static int grid = 0;
    if (grid == 0) {
        if (ws_size < WS_END) { fprintf(stderr, "kernel_launch: workspace too small: %zu < %zu\n", ws_size, (size_t)WS_END); grid = -1; return; }
        int dev = 0, cus = 0, per_cu = 0;
        hipGetDevice(&dev); hipDeviceGetAttribute(&cus, hipDeviceAttributeMultiprocessorCount, dev);
        if (hipFuncSetAttribute((const void*)fwd_kernel, hipFuncAttributeMaxDynamicSharedMemorySize, LDS_BYTES) != hipSuccess) { fprintf(stderr, "kernel_launch: hipFuncSetAttribute failed\n"); grid = -1; return; }
        if (hipOccupancyMaxActiveBlocksPerMultiprocessor(&per_cu, (const void*)fwd_kernel, NTHR, LDS_BYTES) != hipSuccess || per_cu < 1) { fprintf(stderr, "kernel_launch: occupancy query says %d\n", per_cu); per_cu = 1; }
        (void)hipGetLastError();
        grid = cus * 1;
    }
    if (grid < 0) return;
    Params p{};
    p.x = (const float*)d_in[0]; p.pos = (const int*)d_in[1]; p.norm_w = (const float*)d_in[2]; p.fnorm_w = (const float*)d_in[3];
    p.nsa_w_in = (const float*)d_in[4]; p.ck_pos = (const float*)d_in[5]; p.ck_w1 = (const float*)d_in[6]; p.ck_w2 = (const float*)d_in[7];
    p.cv_pos = (const float*)d_in[8]; p.cv_w1 = (const float*)d_in[9]; p.cv_w2 = (const float*)d_in[10]; p.nsa_w_out = (const float*)d_in[11];
    p.hg_w_in = (const float*)d_in[12]; p.hg_lb = (const float*)d_in[13]; p.hg_gn = (const float*)d_in[14]; p.hg_w_out = (const float*)d_in[15];
    p.out = (float*)d_out; p.ws = (unsigned char*)d_ws;
#if DEBUG_CENSUS
    hipMemsetAsync((unsigned char*)d_ws + WS_CBIAS + 2048, 0x7f, 4, stream);
#endif
#if ONE_LAUNCH
    p.ph_lo = 0; p.ph_hi = N_PHASES; p.coop = 1; p.pad = 0;
    void* args[] = {&p};
    hipError_t e = hipLaunchCooperativeKernel((const void*)fwd_kernel, dim3(grid), dim3(NTHR), args, LDS_BYTES, stream);
    if (e != hipSuccess) fprintf(stderr, "cooperative launch failed: %s (grid %d)\n", hipGetErrorString(e), grid);
#else
    for (int ph = 0; ph < N_PHASES; ++ph) {
#ifdef DBG_LAST_PHASE
        if (ph > DBG_LAST_PHASE && ph != 17) continue;
#endif
        p.ph_lo = ph; p.ph_hi = ph + 1; p.coop = 0; p.pad = 0;
        hipLaunchKernelGGL(fwd_kernel, dim3(grid), dim3(NTHR), LDS_BYTES, stream, p);
    }
#endif
}
```

```cpp
#define ONE_LAUNCH 1
#include <hip/hip_runtime.h>
#include <hip/hip_cooperative_groups.h>
#include <cstdio>
namespace cg = cooperative_groups;
__device__ __forceinline__ int get_tid() { int t = threadIdx.x; asm volatile("" : "+v"(t)); return t; }
#ifndef PG8_WGM
#define PG8_WGM 4
#endif
#ifndef ONE_LAUNCH
#define ONE_LAUNCH 0
#endif
#ifndef SANITIZE
#define SANITIZE 0
#endif
namespace pg8 {
#define PG8_LAS __attribute__((address_space(3)))
typedef unsigned short bf16_t;
typedef short bf16x8 __attribute__((ext_vector_type(8)));
typedef float f32x4 __attribute__((ext_vector_type(4)));
typedef unsigned u32x4 __attribute__((ext_vector_type(4)));
constexpr int BM = 256, BK = 64, HALF = 128, HTB = HALF * BK * 2  , STAGE_BYTES = 8 * HTB, NXCD = 8, WGM = PG8_WGM;

__host__ __device__ __forceinline__ int lds_byte(int r, int c) { const int st = (r >> 4) * 2 + (c >> 5), rr = r & 15, cc = c & 31, ob = rr * 64 + cc * 2; return st * 1024 + (ob ^ (((ob >> 9) & 1) << 5)); }
__host__ __device__ __forceinline__ void stage_rc(int b, int& R, int& C) { const int st = b / 1024, sb = b % 1024, swz = sb ^ (((sb >> 9) & 1) << 5); R = (st >> 1) * 16 + swz / 64; C = (st & 1) * 32 + (swz % 64) / 2; }
__host__ __device__ __forceinline__ int perm32(int rho) { const int n = rho >> 4, i = rho & 15; return 8 * (i >> 2) + 4 * n + (i & 3); }

struct Unit { int pm, pn; };
struct Gemm { const bf16_t* A; const bf16_t* Bt; int M, N, K; };

struct StaticOrder {
    int nM, nN, nwg, G, c;
    __host__ __device__ void init(int M, int N, int G_, int c_) { nM = M / BM; nN = N / BM; nwg = nM * nN; G = G_; c = c_; }
    __host__ __device__ bool next(int i, Unit& u) const {
        const long L = (long)i * G + c; if (L >= nwg) return false;
        int wgid = (int)L; { const int q = nwg / NXCD, r = nwg % NXCD, xcd = wgid % NXCD, off = wgid / NXCD; wgid = (xcd < r ? xcd * (q + 1) : r * (q + 1) + (xcd - r) * q) + off; }
        const int nig = WGM * nN, gid = wgid / nig, fm = gid * WGM, gsz = (nM - fm) < WGM ? (nM - fm) : WGM;
        u.pm = fm + ((wgid % nig) % gsz); u.pn = (wgid % nig) / gsz; return true;
    }
    __device__ __forceinline__ void a_ready(const Unit&) const {}
    __device__ __forceinline__ void done(const Unit&) const {}
};
__device__ __forceinline__ unsigned cvt_pk_bf16(float lo, float hi) { unsigned r; asm volatile("v_cvt_pk_bf16_f32 %0, %1, %2" : "=v"(r) : "v"(lo), "v"(hi)); return r; }
typedef float f32x2 __attribute__((ext_vector_type(2)));
template <class Epi, class Sched, bool STAMP = false>
__device__ __forceinline__ void gemm_phase(PG8_LAS unsigned char* lds, const Gemm g, const Sched& S, const Epi& E, unsigned long long* stamps) {
    const int tid = get_tid(), wid = __builtin_amdgcn_readfirstlane(tid >> 6), lane = tid & 63, wr = wid >> 2, wc = wid & 3, fr = lane & 15, fq = lane >> 4;
    const int K = g.K, nt = K / BK;
    int ts_lo = 0, ts_hi = 0, nts = 0; const unsigned long long rt_entry = STAMP ? (unsigned long long)wall_clock64() : 0ull;
#define PG8_STAMP() do { if (STAMP && wid == 0 && nts < 64) { const unsigned long long _c = (unsigned long long)clock64(); \
        ts_lo = (lane == nts) ? (int)(unsigned)_c : ts_lo; ts_hi = (lane == nts) ? (int)(unsigned)(_c >> 32) : ts_hi; ++nts; } } while (0)
    PG8_STAMP();
    unsigned voffA[2], voffB[2];
#pragma unroll
    for (int i = 0; i < 2; ++i) { int R, C; stage_rc(tid * 16 + i * 8192, R, C); const int Rb = Epi::PERM ? ((R & ~31) + perm32(R & 31)) : R;
        voffA[i] = (unsigned)(R * K + C) * 2u; voffB[i] = (unsigned)(Rb * K + C) * 2u; }
    const size_t kstep = (size_t)(BK * 2);
    const size_t hstep = (size_t)HALF * K * 2;
    const size_t tstep = 2 * hstep;
    const unsigned ldsw = (unsigned)wid * 1024u;
    const int aoff = lds_byte(wr * 64 + fr, fq * 8), boff = lds_byte(wc * 32 + fr, fq * 8);
#define PG8_SA(b, h) (((b) * 2 + (h)) * HTB)
#define PG8_SB(b, h) ((4 + (b) * 2 + (h)) * HTB)
#define PG8_STAGE(bufoff, gbase, voff) do { _Pragma("unroll") for (int _i = 0; _i < 2; ++_i) \
        __builtin_amdgcn_global_load_lds((const unsigned*)((const char*)(gbase) + (voff)[_i]), (PG8_LAS unsigned*)(lds + (bufoff) + ldsw + _i * 8192), 16, 0, 0); } while (0)
#define PG8_LDA(dst, b, h) do { _Pragma("unroll") for (int m = 0; m < 4; ++m) _Pragma("unroll") for (int k = 0; k < 2; ++k) dst[m][k] = *(const PG8_LAS bf16x8*)(lds + PG8_SA(b, h) + aoff + m * 2048 + k * 1024); } while (0)
#define PG8_LDB(dst, b, h) do { _Pragma("unroll") for (int n = 0; n < 2; ++n) _Pragma("unroll") for (int k = 0; k < 2; ++k) dst[n][k] = *(const PG8_LAS bf16x8*)(lds + PG8_SB(b, h) + boff + n * 2048 + k * 1024); } while (0)
#define PG8_MMA(ai, bj, At, Bt) do { __builtin_amdgcn_s_setprio(1); _Pragma("unroll") for (int m = 0; m < 4; ++m) _Pragma("unroll") for (int n = 0; n < 2; ++n) _Pragma("unroll") for (int k = 0; k < 2; ++k) \
        acc[ai][bj][m][n] = __builtin_amdgcn_mfma_f32_16x16x32_bf16(Bt[n][k], At[m][k], acc[ai][bj][m][n], 0, 0, 0); __builtin_amdgcn_s_setprio(0); } while (0)
#define PG8_WAIT_V(n) asm volatile("s_waitcnt vmcnt(" #n ")" ::: "memory")
#define PG8_WAIT_L(n) asm volatile("s_waitcnt lgkmcnt(" #n ")" ::: "memory")
#define PG8_BAR __builtin_amdgcn_s_barrier()
#define PG8_SCHED __builtin_amdgcn_sched_barrier(0)
    Unit cur, nxt; int ui = 0;
    if (!S.next(0, cur)) return;
    f32x4 acc[2][2][4][2];
#pragma unroll
    for (int a = 0; a < 2; ++a)
#pragma unroll
        for (int b = 0; b < 2; ++b)
#pragma unroll
            for (int m = 0; m < 4; ++m)
#pragma unroll
                for (int n = 0; n < 2; ++n) acc[a][b][m][n] = (f32x4){0.f, 0.f, 0.f, 0.f};
    bf16x8 At[4][2], B0[2][2], B1[2][2];
    const char* cA = (const char*)g.A + (size_t)cur.pm * tstep; const char* cB = (const char*)g.Bt + (size_t)cur.pn * tstep;
    S.a_ready(cur);
    PG8_STAGE(PG8_SB(0, 0), cB, voffB); PG8_STAGE(PG8_SA(0, 0), cA, voffA); PG8_STAGE(PG8_SB(0, 1), cB + hstep, voffB); PG8_STAGE(PG8_SA(0, 1), cA + hstep, voffA);
    if (wr == 1) PG8_BAR;
    PG8_WAIT_V(4); PG8_BAR;
    PG8_STAGE(PG8_SB(1, 0), cB + kstep, voffB); PG8_STAGE(PG8_SA(1, 0), cA + kstep, voffA); PG8_STAGE(PG8_SB(1, 1), cB + hstep + kstep, voffB);
    PG8_WAIT_V(6); PG8_BAR;
    PG8_STAMP();
    for (;;) {
        const bool has_next = S.next(ui + 1, nxt);
        const char* nA = has_next ? (const char*)g.A + (size_t)nxt.pm * tstep : cA; const char* nB = has_next ? (const char*)g.Bt + (size_t)nxt.pn * tstep : cB;
        for (int t = 0; t < nt; t += 2) {
            const bool last = (t == nt - 2);
            const char* a1 = cA + (size_t)(t + 1) * kstep;
            const char* a2 = last ? nA : cA + (size_t)(t + 2) * kstep; const char* b2 = last ? nB : cB + (size_t)(t + 2) * kstep;
            const char* a3 = a2 + kstep; const char* b3 = b2 + kstep;
            if (last && has_next) S.a_ready(nxt);
            PG8_LDB(B0, 0, 0); PG8_SCHED; PG8_LDA(At, 0, 0); PG8_STAGE(PG8_SA(1, 1), a1 + hstep, voffA);
            PG8_WAIT_L(8); PG8_BAR; PG8_WAIT_L(0); PG8_MMA(0, 0, At, B0); PG8_BAR; PG8_SCHED;
            PG8_LDB(B1, 0, 1); PG8_STAGE(PG8_SB(0, 0), b2, voffB);
            PG8_BAR; PG8_WAIT_L(0); PG8_MMA(0, 1, At, B1); PG8_BAR;
            PG8_LDA(At, 0, 1); PG8_STAGE(PG8_SA(0, 0), a2, voffA);
            PG8_BAR; PG8_WAIT_L(0); PG8_MMA(1, 0, At, B0); PG8_BAR; PG8_SCHED;
            PG8_STAGE(PG8_SB(0, 1), b2 + hstep, voffB);
            PG8_WAIT_V(6); PG8_BAR; PG8_MMA(1, 1, At, B1); PG8_BAR;
            PG8_LDB(B0, 1, 0); PG8_SCHED; PG8_LDA(At, 1, 0); PG8_STAGE(PG8_SA(0, 1), a2 + hstep, voffA);
            PG8_WAIT_L(8); PG8_BAR; PG8_WAIT_L(0); PG8_MMA(0, 0, At, B0); PG8_BAR; PG8_SCHED;
            PG8_LDB(B1, 1, 1); PG8_STAGE(PG8_SB(1, 0), b3, voffB);
            PG8_BAR; PG8_WAIT_L(0); PG8_MMA(0, 1, At, B1); PG8_BAR;
            PG8_LDA(At, 1, 1); PG8_STAGE(PG8_SA(1, 0), a3, voffA);
            PG8_BAR; PG8_WAIT_L(0); PG8_MMA(1, 0, At, B0); PG8_BAR; PG8_SCHED;
            PG8_STAGE(PG8_SB(1, 1), b3 + hstep, voffB);
            PG8_WAIT_V(6); PG8_BAR; PG8_MMA(1, 1, At, B1); PG8_BAR;
        }
        PG8_STAMP();
        if constexpr (!Epi::AFTER_DRAIN) { E(acc, cur, wr, wc, fr, fq); S.done(cur); }
        PG8_STAMP();
        if (!has_next) break;
#pragma unroll
        for (int a = 0; a < 2; ++a)
#pragma unroll
            for (int b = 0; b < 2; ++b)
#pragma unroll
                for (int m = 0; m < 4; ++m)
#pragma unroll
                    for (int n = 0; n < 2; ++n) acc[a][b][m][n] = (f32x4){0.f, 0.f, 0.f, 0.f};
        cur = nxt; cA = nA; cB = nB; ++ui;
    }
    PG8_WAIT_V(0);
    if (wr == 0) PG8_BAR;
    PG8_BAR;
    if constexpr (Epi::AFTER_DRAIN) { E.fused(acc, cur, wr, wc, fr, fq, lds, wid, lane); S.done(cur); }
    PG8_STAMP();
    if (STAMP && wid == 0) { stamps[lane] = lane < nts ? (((unsigned long long)(unsigned)ts_hi << 32) | (unsigned)ts_lo) : 0ull;
        if (lane == 62) stamps[62] = rt_entry; if (lane == 63) stamps[63] = (unsigned long long)wall_clock64(); }
#undef PG8_STAMP
#undef PG8_SA
#undef PG8_SB
#undef PG8_STAGE
#undef PG8_LDA
#undef PG8_LDB
#undef PG8_MMA
#undef PG8_WAIT_V
#undef PG8_WAIT_L
#undef PG8_BAR
#undef PG8_SCHED
}
}
using pg8::bf16_t; using pg8::bf16x8; using pg8::f32x4; using pg8::u32x4; using pg8::cvt_pk_bf16;
typedef short bf16x4 __attribute__((ext_vector_type(4)));
typedef unsigned u32x2 __attribute__((ext_vector_type(2)));

constexpr int NTOK = 16384, SEQ = 8192, DM = 2048, NBATCH = 2;
constexpr int NSA_NP = 7424, NSA_IN = 7216, HG_NP = 8192;
constexpr int Q0 = 0, KC0 = 2048, VC0 = 2560, KS0 = 3072, VS0 = 3584, KW0 = 4096, VW0 = 4608, Z0 = 5120, GL0 = 7168;
constexpr int NTHR = 512;
constexpr int LDS_BYTES = 147456;
constexpr float RMS_EPS = 1e-6f;
constexpr size_t WS_WIN = 0;
constexpr size_t WS_WOUT = WS_WIN + (size_t)8192 * 2048 * 2;
constexpr size_t WS_W1T = WS_WOUT + (size_t)2048 * 2048 * 2;
constexpr size_t WS_W2T = WS_W1T + (size_t)4 * 128 * 4096 * 2;
constexpr size_t WS_CBIAS = WS_W2T + (size_t)4 * 128 * 128 * 2;
constexpr size_t WS_LB = WS_CBIAS + 4096;
constexpr size_t WS_ROPE = WS_LB + (size_t)2 * 2048 * 4;
constexpr size_t WS_SSQ = WS_ROPE + (size_t)NTOK * 32 * 4;
constexpr size_t WS_XB = WS_SSQ + (size_t)5 * NTOK * 4;
constexpr size_t WS_PROJ = WS_XB + (size_t)NTOK * 2048 * 2;
constexpr size_t WS_OBUF = WS_PROJ + (size_t)NTOK * 8192 * 2;
constexpr size_t WS_KCMP = WS_OBUF + (size_t)NTOK * 2048 * 2;
constexpr size_t WS_VCMPT = WS_KCMP + (size_t)8 * 512 * 128 * 2;
constexpr size_t WS_VST = WS_VCMPT + (size_t)8 * 512 * 128 * 2;
constexpr size_t WS_VWT = WS_VST + (size_t)8 * 128 * 8192 * 2;
constexpr size_t WS_HSEG = WS_VST;
constexpr size_t WS_WIN2 = WS_VWT + (size_t)8 * 128 * 8192 * 2;
constexpr int HSEG_STRIDE = 128 * 128 + 128;
constexpr size_t WS_END = WS_WIN2 + (size_t)8192 * 2048 * 2;
static_assert((size_t)256 * HSEG_STRIDE * 4 <= (size_t)2 * 8 * 128 * 8192 * 2, "hseg alias");
constexpr size_t WS_BAR = WS_END;
constexpr size_t WS_END2 = WS_BAR + 16384;

struct Params {
    const float* x; const int* pos; const float* norm_w; const float* fnorm_w;
    const float* nsa_w_in; const float* ck_pos; const float* ck_w1; const float* ck_w2;
    const float* cv_pos; const float* cv_w1; const float* cv_w2; const float* nsa_w_out;
    const float* hg_w_in; const float* hg_lb; const float* hg_gn; const float* hg_w_out;
    float* out; unsigned char* ws; int ph_lo, ph_hi, coop, pad;
};

__device__ __forceinline__ bf16_t f2bf(float f) { unsigned u = __float_as_uint(f); u += 0x7FFFu + ((u >> 16) & 1u); return (bf16_t)(u >> 16); }
__device__ __forceinline__ float bf2f(bf16_t b) { return __uint_as_float(((unsigned)b) << 16); }
__device__ __forceinline__ float bflo(unsigned w) { return __uint_as_float(w << 16); }
__device__ __forceinline__ float bfhi(unsigned w) { return __uint_as_float(w & 0xffff0000u); }
__device__ __forceinline__ f32x4 mfma16(bf16x8 a, bf16x8 b, f32x4 c) { return __builtin_amdgcn_mfma_f32_16x16x32_bf16(a, b, c, 0, 0, 0); }
__device__ __forceinline__ float sigmoidf_(float v) { return __builtin_amdgcn_rcpf(1.0f + __expf(-v)); }
__device__ __forceinline__ float siluf_(float v) { return v * __builtin_amdgcn_rcpf(1.0f + __expf(-v)); }
__device__ __forceinline__ bf16x8 pack8f(const float* v) { u32x4 w = {cvt_pk_bf16(v[0], v[1]), cvt_pk_bf16(v[2], v[3]), cvt_pk_bf16(v[4], v[5]), cvt_pk_bf16(v[6], v[7])}; return *reinterpret_cast<bf16x8*>(&w); }
__device__ __forceinline__ bf16x8 pack44(f32x4 a, f32x4 b) { u32x4 w = {cvt_pk_bf16(a[0], a[1]), cvt_pk_bf16(a[2], a[3]), cvt_pk_bf16(b[0], b[1]), cvt_pk_bf16(b[2], b[3])}; return *reinterpret_cast<bf16x8*>(&w); }

__device__ __forceinline__ float row16_sum(float v) {
    v += __int_as_float(__builtin_amdgcn_update_dpp(0, __float_as_int(v), 0xB1, 0xF, 0xF, true));
    v += __int_as_float(__builtin_amdgcn_update_dpp(0, __float_as_int(v), 0x4E, 0xF, 0xF, true));
    v += __int_as_float(__builtin_amdgcn_update_dpp(0, __float_as_int(v), 0x124, 0xF, 0xF, true));
    v += __int_as_float(__builtin_amdgcn_update_dpp(0, __float_as_int(v), 0x128, 0xF, 0xF, true));
    return v;
}
__device__ __forceinline__ float rows4_sum(float v) {
    { auto r = __builtin_amdgcn_permlane16_swap(__float_as_uint(v), __float_as_uint(v), false, false); v = __uint_as_float(r[0]) + __uint_as_float(r[1]); }
    { auto r = __builtin_amdgcn_permlane32_swap(__float_as_uint(v), __float_as_uint(v), false, false); v = __uint_as_float(r[0]) + __uint_as_float(r[1]); }
    return v;
}
__device__ __forceinline__ int nsa_col(int n) { return n < 5120 ? n : (n < 7168 ? n + 48 : (n < 7216 ? n - 2048 : -1)); }
template <int MODE>
__device__ __forceinline__ void tconv(const float* __restrict__ src, int ldsrc, int nsrc, bf16_t* __restrict__ dst, int Kdim, int Ndst, const float* __restrict__ rowscale, float* tile, int blk, int nblk) {
    const int tid = get_tid(), nkt = Kdim / 64, nnt = Ndst / 64, ntile = nkt * nnt;
    constexpr int TU = 2;
    for (int it0 = blk; it0 < ntile; it0 += TU * nblk) {
        f32x4 v[TU][2];
#pragma unroll
        for (int u = 0; u < TU; ++u) {
            const int it = it0 + u * nblk;
            if (it < ntile) {
                const int k0 = (it % nkt) * 64, n0 = (it / nkt) * 64;
#pragma unroll
                for (int i = 0; i < 2; ++i) {
                    const int kr = (tid >> 4) + 32 * i, c4 = (tid & 15) * 4, n = n0 + c4;
                    const int sc = MODE == 1 ? nsa_col(n) : (n < nsrc ? n : -1);
                    v[u][i] = (f32x4){0.f, 0.f, 0.f, 0.f};
                    if (sc >= 0) v[u][i] = *(const f32x4*)(src + (size_t)(k0 + kr) * ldsrc + sc);
                    if (rowscale) { const float s = rowscale[k0 + kr]; v[u][i] = v[u][i] * s; }
                }
            }
        }
        __syncthreads();
#pragma unroll
        for (int u = 0; u < TU; ++u)
#pragma unroll
            for (int i = 0; i < 2; ++i) {
                const int kr = (tid >> 4) + 32 * i, c4 = (tid & 15) * 4; float* tl = tile + u * (64 * 65);
                tl[kr * 65 + c4 + 0] = v[u][i][0]; tl[kr * 65 + c4 + 1] = v[u][i][1]; tl[kr * 65 + c4 + 2] = v[u][i][2]; tl[kr * 65 + c4 + 3] = v[u][i][3];
            }
        __syncthreads();
#pragma unroll
        for (int u = 0; u < TU; ++u) {
            const int it = it0 + u * nblk;
            if (it < ntile) {
                const int k0 = (it % nkt) * 64, n0 = (it / nkt) * 64; const float* tl = tile + u * (64 * 65);
                const int nr = tid >> 3, k8 = (tid & 7) * 8; float o[8];
#pragma unroll
                for (int j = 0; j < 8; ++j) o[j] = tl[(k8 + j) * 65 + nr];
                *(bf16x8*)(dst + (size_t)(n0 + nr) * Kdim + k0 + k8) = pack8f(o);
            }
        }
    }
    __syncthreads();
}

struct EpiNsaIn {
    static constexpr bool PERM = true, AFTER_DRAIN = false;
    bf16_t* proj; const float* ssq; const float* rope;
    __device__ __forceinline__ void operator()(const f32x4 (&acc)[2][2][4][2], const pg8::Unit& u, int wr, int wc, int fr, int fq) const {
        const int pn = u.pn;
        const bool is_rope = (pn < 10) || pn == 12 || pn == 13 || pn == 16 || pn == 17;
        const int mode = (pn >= 20 && pn < 28) ? 1 : (pn == 28 ? 2 : 0);
        const bool do_rope = is_rope && (wc == 0);
#pragma unroll
        for (int ai = 0; ai < 2; ++ai)
#pragma unroll
            for (int m = 0; m < 4; ++m) {
                const int row = u.pm * 256 + ai * 128 + wr * 64 + m * 16 + fr;
                const float rs = rsqrtf(ssq[row] * (1.0f / 2048.0f) + RMS_EPS);
                f32x4 c0 = {1.f, 1.f, 1.f, 1.f}, c1 = c0, s0 = {0.f, 0.f, 0.f, 0.f}, s1 = s0;
                if (do_rope) { const float* cp = rope + (size_t)row * 32 + 8 * (fq & 1); c0 = *(const f32x4*)cp; c1 = *(const f32x4*)(cp + 4); s0 = *(const f32x4*)(cp + 16); s1 = *(const f32x4*)(cp + 20);
                    if (fq < 2) { s0 = -s0; s1 = -s1; } }
#pragma unroll
                for (int bj = 0; bj < 2; ++bj) {
                    float v[8];
#pragma unroll
                    for (int j = 0; j < 4; ++j) { v[j] = acc[ai][bj][m][0][j] * rs; v[4 + j] = acc[ai][bj][m][1][j] * rs; }
                    if (do_rope) {
#pragma unroll
                        for (int e = 0; e < 8; ++e) { const auto sw = __builtin_amdgcn_permlane32_swap(__float_as_uint(v[e]), __float_as_uint(v[e]), false, false); const float pr = __uint_as_float(fq < 2 ? sw[1] : sw[0]);     const float c = e < 4 ? c0[e & 3] : c1[e & 3], s = e < 4 ? s0[e & 3] : s1[e & 3]; v[e] = v[e] * c + pr * s; }
                    }
                    if (mode == 1) {
#pragma unroll
                        for (int e = 0; e < 8; ++e) v[e] = siluf_(v[e]);
                    } else if (mode == 2) {
#pragma unroll
                        for (int e = 0; e < 8; ++e) v[e] = sigmoidf_(v[e]);
                    }
                    *(bf16x8*)(proj + (size_t)row * NSA_NP + pn * 256 + bj * 128 + wc * 32 + 8 * fq) = pack8f(v);
                }
            }
    }
};
struct EpiHgIn {
    static constexpr bool PERM = true, AFTER_DRAIN = false;
    bf16_t* proj; const float* ssq; const float* lb;
    __device__ __forceinline__ void operator()(const f32x4 (&acc)[2][2][4][2], const pg8::Unit& u, int wr, int wc, int fr, int fq) const {
        const int pn = u.pn; const int mode = pn < 8 ? 1 : (pn < 16 ? 3 : (pn < 24 ? 0 : 1));
#pragma unroll
        for (int ai = 0; ai < 2; ++ai)
#pragma unroll
            for (int m = 0; m < 4; ++m) {
                const int row = u.pm * 256 + ai * 128 + wr * 64 + m * 16 + fr;
                const float rs = rsqrtf(ssq[row] * (1.0f / 2048.0f) + RMS_EPS);
#pragma unroll
                for (int bj = 0; bj < 2; ++bj) {
                    const int col = pn * 256 + bj * 128 + wc * 32 + 8 * fq;
                    float v[8];
#pragma unroll
                    for (int j = 0; j < 4; ++j) { v[j] = acc[ai][bj][m][0][j] * rs; v[4 + j] = acc[ai][bj][m][1][j] * rs; }
                    if (mode == 1) {
#pragma unroll
                        for (int e = 0; e < 8; ++e) v[e] = siluf_(v[e]);
                    } else if (mode == 3) {
                        const f32x4 l0 = *(const f32x4*)(lb + col - 2048), l1 = *(const f32x4*)(lb + col - 2048 + 4);
#pragma unroll
                        for (int e = 0; e < 8; ++e) { const float l = e < 4 ? l0[e & 3] : l1[e & 3]; const float f = l + (1.0f - l) * sigmoidf_(v[e]); v[e] = __logf(f); }
                    }
                    *(bf16x8*)(proj + (size_t)row * HG_NP + col) = pack8f(v);
                }
            }
    }
};
struct EpiPlain {
    static constexpr bool PERM = true, AFTER_DRAIN = false;
    bf16_t* proj; int ldc;
    __device__ __forceinline__ void operator()(const f32x4 (&acc)[2][2][4][2], const pg8::Unit& u, int wr, int wc, int fr, int fq) const {
#pragma unroll
        for (int ai = 0; ai < 2; ++ai)
#pragma unroll
            for (int m = 0; m < 4; ++m) { const int row = u.pm * 256 + ai * 128 + wr * 64 + m * 16 + fr;
#pragma unroll
                for (int bj = 0; bj < 2; ++bj) *(bf16x8*)(proj + (size_t)row * ldc + u.pn * 256 + bj * 128 + wc * 32 + 8 * fq) = pack44(acc[ai][bj][m][0], acc[ai][bj][m][1]); }
    }
};
struct EpiOut {
    static constexpr bool PERM = false, AFTER_DRAIN = false;
    const float* xin; float* xout; bf16_t* xb; float* ssq;
    __device__ __forceinline__ void operator()(const f32x4 (&acc)[2][2][4][2], const pg8::Unit& u, int wr, int wc, int fr, int fq) const {
#pragma unroll
        for (int ai = 0; ai < 2; ++ai)
#pragma unroll
            for (int m = 0; m < 4; ++m) {
                const int row = u.pm * 256 + ai * 128 + wr * 64 + m * 16 + fr; float ss = 0.f;
#pragma unroll
                for (int bj = 0; bj < 2; ++bj)
#pragma unroll
                    for (int n = 0; n < 2; ++n) {
                        const size_t off = (size_t)row * DM + u.pn * 256 + bj * 128 + wc * 32 + n * 16 + 4 * fq;
                        const f32x4 xo = *(const f32x4*)(xin + off); const f32x4 xn = xo + acc[ai][bj][m][n];
                        *(f32x4*)(xout + off) = xn;
                        u32x2 w; w.x = cvt_pk_bf16(xn[0], xn[1]); w.y = cvt_pk_bf16(xn[2], xn[3]); *(u32x2*)(xb + off) = w;
                        ss += xn[0] * xn[0] + xn[1] * xn[1] + xn[2] * xn[2] + xn[3] * xn[3];
                    }
                ss = rows4_sum(ss);
                if (fq == 0) atomicAdd(ssq + row, ss);
            }
    }
};
__device__ __forceinline__ void phase_prep(const Params& p, unsigned char* smem) {
    const int tid = get_tid(), lane = tid & 63, wave = tid >> 6, blk = blockIdx.x, nblk = gridDim.x;
    unsigned char* ws = p.ws;
    float* ssq = (float*)(ws + WS_SSQ); bf16_t* xb = (bf16_t*)(ws + WS_XB);
    for (int row = blk * 8 + wave; row < NTOK; row += nblk * 8) {
        const float* xr = p.x + (size_t)row * DM; float ss = 0.f;
#pragma unroll
        for (int i = 0; i < 4; ++i) {
            const int c = (i * 64 + lane) * 8; const f32x4 a = *(const f32x4*)(xr + c), b = *(const f32x4*)(xr + c + 4);
            ss += a[0] * a[0] + a[1] * a[1] + a[2] * a[2] + a[3] * a[3] + b[0] * b[0] + b[1] * b[1] + b[2] * b[2] + b[3] * b[3];
            *(bf16x8*)(xb + (size_t)row * DM + c) = pack44(a, b);
        }
#pragma unroll
        for (int o = 32; o >= 1; o >>= 1) ss += __shfl_xor(ss, o);
        if (lane == 0) ssq[row] = ss;
    }
    const int gtid = blk * NTHR + tid, gn = nblk * NTHR;
    for (int i = gtid; i < 4 * NTOK; i += gn) ssq[NTOK + i] = 0.f;
    float* rope = (float*)(ws + WS_ROPE);
    for (int i = gtid; i < NTOK * 16; i += gn) {
        const int t = i >> 4, f = i & 15;
        const float inv = powf(500000.0f, -(float)f / 16.0f);
        const float ang = (float)p.pos[t] * inv;
        double fr = (double)ang * 0.15915494309189533577; fr -= rint(fr);
        rope[t * 32 + f] = __builtin_amdgcn_cosf((float)fr); rope[t * 32 + 16 + f] = __builtin_amdgcn_sinf((float)fr);
    }
    if (gtid < 2) ((unsigned*)(ws + WS_CBIAS + 2048 + 64))[gtid] = 0u;
    float* lb = (float*)(ws + WS_LB);
    for (int i = gtid; i < 2048; i += gn) { const float a0 = p.hg_lb[i], a1 = p.hg_lb[2048 + i]; lb[i] = 0.f; lb[2048 + i] = 1.0f / (1.0f + __expf(a0 - a1)); }
    float* cb = (float*)(ws + WS_CBIAS);
    for (int it = blk * 8 + wave; it < 512; it += nblk * 8) {
        const int which = it >> 7, h = it & 127, layer = which >> 1;
        const float* pos = ((which & 1) ? p.cv_pos : p.ck_pos) + (size_t)layer * 4096;
        const float* w1 = ((which & 1) ? p.cv_w1 : p.ck_w1) + (size_t)layer * 4096 * 128;
        float s = 0.f;
        for (int k = lane; k < 4096; k += 64) s += pos[k] * w1[(size_t)k * 128 + h];
#pragma unroll
        for (int o = 32; o >= 1; o >>= 1) s += __shfl_xor(s, o);
        if (lane == 0) cb[which * 128 + h] = s;
    }
    float* tile = (float*)smem;
    for (int which = 0; which < 4; ++which) {
        const int layer = which >> 1;
        const float* w1 = ((which & 1) ? p.cv_w1 : p.ck_w1) + (size_t)layer * 4096 * 128;
        const float* w2 = ((which & 1) ? p.cv_w2 : p.ck_w2) + (size_t)layer * 128 * 128;
        tconv<0>(w1, 128, 128, (bf16_t*)(ws + WS_W1T) + (size_t)which * 128 * 4096, 4096, 128, nullptr, tile, blk, nblk);
        tconv<0>(w2, 128, 128, (bf16_t*)(ws + WS_W2T) + (size_t)which * 128 * 128, 128, 128, nullptr, tile, blk, nblk);
    }
    tconv<1>(p.nsa_w_in, NSA_IN, NSA_IN, (bf16_t*)(ws + WS_WIN), 2048, NSA_NP, p.norm_w, tile, blk, nblk);
}

__device__ __forceinline__ void compress_item(const Params& p, int nl, int item, unsigned char* smem) {
    const int tid = get_tid(), lane = tid & 63, w = tid >> 6, l15 = lane & 15, quad = lane >> 4;
    const int kv = item >> 7, bg = (item >> 4) & 7, nt = item & 15, b = bg >> 2, g = bg & 3, n0 = nt * 32;
    const int which = nl * 2 + kv;
    unsigned char* ws = p.ws;
    const bf16_t* proj = (const bf16_t*)(ws + WS_PROJ);
    const bf16_t* w1t = (const bf16_t*)(ws + WS_W1T) + (size_t)which * 128 * 4096;
    const bf16_t* w2t = (const bf16_t*)(ws + WS_W2T) + (size_t)which * 128 * 128;
    const float* cb = (const float*)(ws + WS_CBIAS) + which * 128;
    const int col0 = (kv ? VC0 : KC0) + g * 128;
    f32x4 acc[2] = {{0.f, 0.f, 0.f, 0.f}, {0.f, 0.f, 0.f, 0.f}};
    const bf16_t* brow = w1t + (size_t)(16 * w + l15) * 4096 + quad * 8;
    constexpr int CAP = 264, CABUF = 32 * 264 * 2;
    unsigned char* abuf = smem + 16384;
    bf16x8 areg[2];
#define CMP_LOAD(gg) do { _Pragma("unroll") for (int i_ = 0; i_ < 2; ++i_) { const int id_ = tid + 512 * i_, n_ = id_ >> 5, c8_ = (id_ & 31) * 8; \
        int tok_ = 16 * (n0 + n_) + 2 * (gg) + (c8_ >> 7); tok_ = tok_ > SEQ - 1 ? SEQ - 1 : tok_; \
        areg[i_] = *(const bf16x8*)(proj + (size_t)(b * SEQ + tok_) * NSA_NP + col0 + (c8_ & 127)); } } while (0)
#define CMP_WRITE(bufp) do { _Pragma("unroll") for (int i_ = 0; i_ < 2; ++i_) { const int id_ = tid + 512 * i_, n_ = id_ >> 5, c8_ = (id_ & 31) * 8; \
        *(bf16x8*)((bf16_t*)(bufp) + n_ * CAP + c8_) = areg[i_]; } } while (0)
    CMP_LOAD(0);
    __syncthreads();
    CMP_WRITE(abuf);
    __syncthreads();
    CMP_LOAD(1);
    for (int gg = 0; gg < 16; ++gg) {
        const bf16_t* sA = (const bf16_t*)(abuf + (gg & 1) * CABUF);
        bf16x8 bf[8];
#pragma unroll
        for (int kk = 0; kk < 8; ++kk) bf[kk] = *(const bf16x8*)(brow + (gg * 8 + kk) * 32);
#pragma unroll
        for (int kk = 0; kk < 8; ++kk)
#pragma unroll
            for (int rt = 0; rt < 2; ++rt) {
                const bf16x8 af = *(const bf16x8*)(sA + (rt * 16 + l15) * CAP + kk * 32 + quad * 8);
                acc[rt] = mfma16(af, bf[kk], acc[rt]);
            }
        if (gg + 1 < 16) CMP_WRITE(abuf + ((gg & 1) ^ 1) * CABUF);
        __syncthreads();
        if (gg + 2 < 16) CMP_LOAD(gg + 2);
    }
#undef CMP_LOAD
#undef CMP_WRITE
    bf16_t* sHid = (bf16_t*)smem;
    __syncthreads();
    { const float bias = cb[16 * w + l15];
#pragma unroll
      for (int rt = 0; rt < 2; ++rt)
#pragma unroll
          for (int j = 0; j < 4; ++j) sHid[(rt * 16 + quad * 4 + j) * 136 + 16 * w + l15] = f2bf(siluf_(acc[rt][j] + bias)); }
    __syncthreads();
    f32x4 oc[2] = {{0.f, 0.f, 0.f, 0.f}, {0.f, 0.f, 0.f, 0.f}};
#pragma unroll
    for (int kk = 0; kk < 4; ++kk) {
        const bf16x8 bf = *(const bf16x8*)(w2t + (size_t)(16 * w + l15) * 128 + kk * 32 + quad * 8);
#pragma unroll
        for (int rt = 0; rt < 2; ++rt) { const bf16x8 af = *(const bf16x8*)(sHid + (rt * 16 + l15) * 136 + kk * 32 + quad * 8); oc[rt] = mfma16(af, bf, oc[rt]); }
    }
    if (kv == 0) {
        bf16_t* kc = (bf16_t*)(ws + WS_KCMP) + (size_t)bg * 512 * 128;
#pragma unroll
        for (int rt = 0; rt < 2; ++rt)
#pragma unroll
            for (int j = 0; j < 4; ++j) { const int n = n0 + rt * 16 + quad * 4 + j; kc[(size_t)n * 128 + 16 * w + l15] = n < 511 ? f2bf(oc[rt][j]) : (bf16_t)0; }
    } else {
        bf16_t* vct = (bf16_t*)(ws + WS_VCMPT) + (size_t)bg * 128 * 512;
#pragma unroll
        for (int rt = 0; rt < 2; ++rt) {
            const int n = n0 + rt * 16 + quad * 4; f32x4 v = oc[rt]; if (n + 3 >= 511) v[3] = 0.f;
            u32x2 wv; wv.x = cvt_pk_bf16(v[0], v[1]); wv.y = cvt_pk_bf16(v[2], v[3]);
            *(u32x2*)(vct + (size_t)(16 * w + l15) * 512 + n) = wv;
        }
    }
    __syncthreads();
}
__device__ __forceinline__ void vtrans_item(const Params& p, int item, unsigned char* smem) {
    const int tid = get_tid(); const int which = item >> 10, bg = (item >> 7) & 7, tt = item & 127, b = bg >> 2, g = bg & 3, s0 = tt * 64;
    const bf16_t* proj = (const bf16_t*)(p.ws + WS_PROJ);
    bf16_t* dst = (bf16_t*)(p.ws + (which ? WS_VWT : WS_VST)) + (size_t)bg * 128 * SEQ;
    const int col0 = (which ? VW0 : VS0) + g * 128;
    bf16_t* t = (bf16_t*)smem;
    __syncthreads();
#pragma unroll
    for (int i = 0; i < 2; ++i) { const int c = tid + 512 * i, r = c >> 4, c8 = (c & 15) * 8;
        *(bf16x8*)(t + r * 136 + c8) = *(const bf16x8*)(proj + (size_t)(b * SEQ + s0 + r) * NSA_NP + col0 + c8); }
    __syncthreads();
    { const int d = tid >> 2, k16 = (tid & 3) * 16; bf16x8 o0, o1;
#pragma unroll
      for (int j = 0; j < 8; ++j) { o0[j] = (short)t[(k16 + j) * 136 + d]; o1[j] = (short)t[(k16 + 8 + j) * 136 + d]; }
      *(bf16x8*)(dst + (size_t)d * SEQ + s0 + k16) = o0; *(bf16x8*)(dst + (size_t)d * SEQ + s0 + k16 + 8) = o1; }
}
#ifndef ATT_SKIP
#define ATT_SKIP 0
#endif
#ifndef ATT_REPEAT
#define ATT_REPEAT 0
#endif
#ifndef DEBUG_TIMER
#define DEBUG_TIMER 0
#endif
#if DEBUG_TIMER
#define TMR_BEGIN(k) unsigned long long tmr_##k = wall_clock64();
#define TMR_END(k) if (blockIdx.x == DEBUG_TIMER_BLOCK && tid == 0 && ((DEBUG_TIMER >> k) & 1)) { unsigned long long* acc_t = (unsigned long long*)(p.ws + WS_CBIAS + 2048 + 16); *acc_t += wall_clock64() - tmr_##k; }
#else
#define TMR_BEGIN(k)
#define TMR_END(k)
#endif
constexpr int SKP = 136, SVP = 72;
constexpr int A_BUFSZ = 35840, A_SVOFF = 17408, A_IMP = 71680, A_ACC = 71680, A_ACCW = 8704, A_SEL = 141312;
constexpr float ATT_C2 = 0.08838834764831845f * 1.4426950408889634f;

__device__ __forceinline__ float xrow_max(float v) {
    { auto r = __builtin_amdgcn_permlane16_swap(__float_as_uint(v), __float_as_uint(v), false, false); v = fmaxf(__uint_as_float(r[0]), __uint_as_float(r[1])); }
    { auto r = __builtin_amdgcn_permlane32_swap(__float_as_uint(v), __float_as_uint(v), false, false); v = fmaxf(__uint_as_float(r[0]), __uint_as_float(r[1])); }
    return v;
}
__device__ __forceinline__ float xrow_sum(float v) {
    { auto r = __builtin_amdgcn_permlane16_swap(__float_as_uint(v), __float_as_uint(v), false, false); v = __uint_as_float(r[0]) + __uint_as_float(r[1]); }
    { auto r = __builtin_amdgcn_permlane32_swap(__float_as_uint(v), __float_as_uint(v), false, false); v = __uint_as_float(r[0]) + __uint_as_float(r[1]); }
    return v;
}
__device__ __forceinline__ float quad_sum(float v) {
    v += __int_as_float(__builtin_amdgcn_update_dpp(0, __float_as_int(v), 0xB1, 0xF, 0xF, true));
    v += __int_as_float(__builtin_amdgcn_update_dpp(0, __float_as_int(v), 0x4E, 0xF, 0xF, true));
    return v;
}
template <int MODE>
__device__ __forceinline__ void attn_softmax(f32x4 (&st)[4], int tpos, int key0, bool need_mask, bool rowsel, float& mrow, float& lrow, f32x4 (&oq)[8], bf16x8 (&pf)[2], float il, float* impRow, int lane) {
    const int quad = lane >> 4;
    float x[4][4]; float mx = -1e30f;
#pragma unroll
    for (int kt = 0; kt < 4; ++kt)
#pragma unroll
        for (int j = 0; j < 4; ++j) {
            float v = st[kt][j];
            if (need_mask) {
                const int key = key0 + kt * 16 + quad * 4 + j; bool vis;
                if (MODE <= 1) vis = (16 * key + 31 <= tpos);
                else if (MODE == 2) vis = (key <= tpos) && (key > tpos - 512);
                else vis = (key <= tpos);
                v = vis ? v : -1e30f;
            }
            x[kt][j] = v; mx = fmaxf(mx, v);
        }
    if (MODE == 1) {
        const float me = mrow > -1e29f ? mrow : 1e30f;
#pragma unroll
        for (int kt = 0; kt < 4; ++kt) {
#pragma unroll
            for (int j = 0; j < 4; ++j) x[kt][j] = __builtin_amdgcn_exp2f(fmaxf(x[kt][j] - me, -126.f)) * il;
        }
        float A[4], E[4];
#pragma unroll
        for (int kt = 0; kt < 4; ++kt) { A[kt] = (x[kt][0] + x[kt][1]) + (x[kt][2] + x[kt][3]); E[kt] = x[kt][3];
            A[kt] = quad_sum(A[kt]); E[kt] = quad_sum(E[kt]); }
        if ((lane & 3) == 0) {
#pragma unroll
            for (int kt = 0; kt < 4; ++kt) impRow[key0 / 4 + kt * 4 + quad] += A[kt];
            asm volatile("s_waitcnt lgkmcnt(0)" ::: "memory");
#pragma unroll
            for (int kt = 0; kt < 4; ++kt) impRow[key0 / 4 + kt * 4 + quad + 1] += E[kt];
        }
    } else {
        if (MODE == 3) mx = rowsel ? mx : -1e30f;
        mx = xrow_max(mx);
        const float mn = fmaxf(mrow, mx);
        const float alpha = __builtin_amdgcn_exp2f(fmaxf(mrow - mn, -126.f)); mrow = mn;
        const float me = (mn > -1e29f && (MODE != 3 || rowsel)) ? mn : 1e30f;
        float rs = 0.f;
#pragma unroll
        for (int kt = 0; kt < 4; ++kt)
#pragma unroll
            for (int j = 0; j < 4; ++j) { x[kt][j] = __builtin_amdgcn_exp2f(fmaxf(x[kt][j] - me, -126.f)); rs += x[kt][j]; }
        rs = xrow_sum(rs);
        lrow = lrow * alpha + rs;
        if (MODE != 0) { if (__any((int)(alpha != 1.0f))) {
#pragma unroll
            for (int dt = 0; dt < 8; ++dt) oq[dt] = oq[dt] * alpha; } }
    }
    if (MODE != 0) {
#pragma unroll
        for (int ks = 0; ks < 2; ++ks) {
            u32x4 wv = {cvt_pk_bf16(x[2 * ks][0], x[2 * ks][1]), cvt_pk_bf16(x[2 * ks][2], x[2 * ks][3]), cvt_pk_bf16(x[2 * ks + 1][0], x[2 * ks + 1][1]), cvt_pk_bf16(x[2 * ks + 1][2], x[2 * ks + 1][3])};
            pf[ks] = *reinterpret_cast<bf16x8*>(&wv);
        }
    }
}

template <int MODE>
__device__ __forceinline__ void attn_branch(const bf16_t* __restrict__ kbase, int kpitch, const bf16_t* __restrict__ vtbase, int vtile, int vrow, int t_lo, int t_hi,
                                            const bf16x8 (&qf)[2][4], const int (&tq)[2], float (&mrow)[2], float (&lrow)[2], f32x4 (&o)[2][8],
                                            const unsigned long long (&selm)[2][2], unsigned char* smem, int wtok0, int qi) {
    const int tid = get_tid(), lane = tid & 63, w = tid >> 6, l15 = lane & 15, quad = lane >> 4;
    float* sImp = (float*)(smem + A_IMP); const unsigned* sSelW = (const unsigned*)(smem + A_SEL) + w * 8 * 4;
    bf16x8 kregA[2], vregA[2], kregB[2], vregB[2];
    const int krow = tid >> 4, kc8 = (tid & 15) * 8, vd = tid >> 3, vk8 = (tid & 7) * 8;
#define ATT_LOAD(kreg, vreg, tt) do { _Pragma("unroll") for (int i_ = 0; i_ < 2; ++i_) { kreg[i_] = *(const bf16x8*)(kbase + (size_t)((tt) * 64 + krow + 32 * i_) * kpitch + kc8); \
        if (MODE != 0) vreg[i_] = *(const bf16x8*)(vtbase + (size_t)(tt) * vtile + (size_t)(vd + 64 * i_) * vrow + vk8); } } while (0)
#define ATT_WRITE(kreg, vreg, bufp) do { _Pragma("unroll") for (int i_ = 0; i_ < 2; ++i_) { *(bf16x8*)((bf16_t*)(bufp) + (krow + 32 * i_) * SKP + kc8) = kreg[i_]; \
        if (MODE != 0) { bf16_t* vrow_ = (bf16_t*)((bufp) + A_SVOFF) + (vd + 64 * i_) * SVP + (vk8 & 32); const int m_ = (vk8 >> 3) & 3; \
            const bf16x4 p0_ = {vreg[i_][0], vreg[i_][1], vreg[i_][2], vreg[i_][3]}, p1_ = {vreg[i_][4], vreg[i_][5], vreg[i_][6], vreg[i_][7]}; \
            *(bf16x4*)(vrow_ + 8 * ((2 * m_) & 3) + 4 * (m_ >> 1)) = p0_; *(bf16x4*)(vrow_ + 8 * ((2 * m_ + 1) & 3) + 4 * (m_ >> 1)) = p1_; } } } while (0)
    constexpr bool DEEP = false;
    if (t_lo < t_hi) ATT_LOAD(kregA, vregA, t_lo);
    if (DEEP) { if (t_lo + 1 < t_hi) ATT_LOAD(kregB, vregB, t_lo + 1); }
    __syncthreads();
    if (t_lo < t_hi) ATT_WRITE(kregA, vregA, smem);
    __syncthreads();
    if (DEEP) { if (t_lo + 2 < t_hi) ATT_LOAD(kregA, vregA, t_lo + 2); }
    else { if (t_lo + 1 < t_hi) ATT_LOAD(kregA, vregA, t_lo + 1); }
    float il1[2] = {0.f, 0.f};
    if (MODE == 1) {
#pragma unroll
        for (int qt = 0; qt < 2; ++qt) il1[qt] = (mrow[qt] > -1e29f && lrow[qt] > 0.f) ? 1.0f / lrow[qt] : 0.f;
    }
#define ATT_BODY(t, bufsel) do { \
        unsigned char* buf = smem + (bufsel) * A_BUFSZ; \
        const bf16_t* sK = (const bf16_t*)buf; const bf16_t* sVt = (const bf16_t*)(buf + A_SVOFF); \
        const int key0 = t * 64; \
        bool need_mask; \
        if (MODE <= 1) need_mask = (16 * (key0 + 63) + 31 > wtok0); \
        else if (MODE == 2) need_mask = (t == qi - 8) || (t == qi); \
        else need_mask = (t == qi); \
        bool rsel[2] = {true, true}; bool both = true; \
        if (MODE == 3) { \
_Pragma("unroll") \
            for (int qt = 0; qt < 2; ++qt) rsel[qt] = ((sSelW[(qt * 4 + (l15 >> 2)) * 4 + (t >> 5)] >> (t & 31)) & 1u) != 0u; \
            both = false; \
        } \
        if (MODE != 3) { \
            f32x4 st[2][4]; \
_Pragma("unroll") \
            for (int qt = 0; qt < 2; ++qt) \
_Pragma("unroll") \
                for (int kt = 0; kt < 4; ++kt) st[qt][kt] = (f32x4){0.f, 0.f, 0.f, 0.f}; \
_Pragma("unroll") \
            for (int kk = 0; kk < 4; ++kk) { \
                bf16x8 a4[4]; \
_Pragma("unroll") \
                for (int kt = 0; kt < 4; ++kt) a4[kt] = *(const bf16x8*)(sK + (kt * 16 + l15) * SKP + kk * 32 + quad * 8); \
                __builtin_amdgcn_sched_barrier(0); \
_Pragma("unroll") \
                for (int kt = 0; kt < 4; ++kt) { st[0][kt] = mfma16(a4[kt], qf[0][kk], st[0][kt]); st[1][kt] = mfma16(a4[kt], qf[1][kk], st[1][kt]); } \
                __builtin_amdgcn_sched_barrier(0); \
            } \
            bf16x8 pf[2][2]; \
_Pragma("unroll") \
            for (int qt = 0; qt < 2; ++qt) \
                attn_softmax<MODE>(st[qt], tq[qt], key0, need_mask, rsel[qt], mrow[qt], lrow[qt], o[qt], pf[qt], il1[qt], sImp + (w * 8 + qt * 4 + (l15 >> 2)) * 132, lane); \
            if (MODE != 0) { \
_Pragma("unroll") \
                for (int ks = 0; ks < 2; ++ks) \
_Pragma("unroll") \
                    for (int dh = 0; dh < 2; ++dh) { \
                        bf16x4 lo4[4], hi4[4]; \
_Pragma("unroll") \
                        for (int di = 0; di < 4; ++di) { const bf16x8 vv = *(const bf16x8*)(sVt + ((dh * 4 + di) * 16 + l15) * SVP + ks * 32 + quad * 8); lo4[di] = (bf16x4){vv[0], vv[1], vv[2], vv[3]}; hi4[di] = (bf16x4){vv[4], vv[5], vv[6], vv[7]}; } \
                        __builtin_amdgcn_sched_barrier(0); \
_Pragma("unroll") \
                        for (int di = 0; di < 4; ++di) { const int dt = dh * 4 + di; \
                            const bf16x8 a = {lo4[di][0], lo4[di][1], lo4[di][2], lo4[di][3], hi4[di][0], hi4[di][1], hi4[di][2], hi4[di][3]}; \
                            o[0][dt] = mfma16(a, pf[0][ks], o[0][dt]); \
                            o[1][dt] = mfma16(a, pf[1][ks], o[1][dt]); } \
                        __builtin_amdgcn_sched_barrier(0); \
                    } \
            } \
        } else if (both) { \
            bf16x8 pf[2][2]; \
_Pragma("unroll") \
            for (int qt = 0; qt < 2; ++qt) { \
                f32x4 st[4]; bf16x8 ap[2][4]; bf16x4 vlo[2][4], vhi[2][4]; \
_Pragma("unroll") \
                for (int kt = 0; kt < 4; ++kt) st[kt] = (f32x4){0.f, 0.f, 0.f, 0.f}; \
_Pragma("unroll") \
                for (int kk = 0; kk < 4; ++kk) { \
                    if (kk == 0) { \
_Pragma("unroll") \
                        for (int kt = 0; kt < 4; ++kt) ap[0][kt] = *(const bf16x8*)(sK + (kt * 16 + l15) * SKP + quad * 8); } \
                    if (kk + 1 < 4) { \
_Pragma("unroll") \
                        for (int kt = 0; kt < 4; ++kt) ap[(kk + 1) & 1][kt] = *(const bf16x8*)(sK + (kt * 16 + l15) * SKP + (kk + 1) * 32 + quad * 8); } \
                    __builtin_amdgcn_sched_barrier(0); \
_Pragma("unroll") \
                    for (int kt = 0; kt < 4; ++kt) st[kt] = mfma16(ap[kk & 1][kt], qf[qt][kk], st[kt]); \
                    __builtin_amdgcn_sched_barrier(0); \
                } \
                attn_softmax<MODE>(st, tq[qt], key0, need_mask, rsel[qt], mrow[qt], lrow[qt], o[qt], pf[qt], 0.f, sImp, lane); \
            } \
_Pragma("unroll") \
            for (int dt = 0; dt < 8; ++dt) \
_Pragma("unroll") \
                for (int ks = 0; ks < 2; ++ks) { \
                    const bf16_t* vp = sVt + (dt * 16 + l15) * SVP + ks * 32 + quad * 4; \
                    const bf16x4 lo = *(const bf16x4*)vp, hi = *(const bf16x4*)(vp + 16); \
                    const bf16x8 a = {lo[0], lo[1], lo[2], lo[3], hi[0], hi[1], hi[2], hi[3]}; \
                    o[0][dt] = mfma16(a, pf[0][ks], o[0][dt]); \
                    o[1][dt] = mfma16(a, pf[1][ks], o[1][dt]); \
                } \
        } else { \
_Pragma("unroll") \
            for (int qt = 0; qt < 2; ++qt) { \
                const bool rowsel = rsel[qt]; \
                if (__any((int)rowsel) == 0) continue; \
                f32x4 st[4]; bf16x8 ap[2][4]; bf16x4 vlo[2][4], vhi[2][4]; \
_Pragma("unroll") \
                for (int kt = 0; kt < 4; ++kt) st[kt] = (f32x4){0.f, 0.f, 0.f, 0.f}; \
_Pragma("unroll") \
                for (int kk = 0; kk < 4; ++kk) { \
                    if (kk == 0) { \
_Pragma("unroll") \
                        for (int kt = 0; kt < 4; ++kt) ap[0][kt] = *(const bf16x8*)(sK + (kt * 16 + l15) * SKP + quad * 8); } \
                    if (kk + 1 < 4) { \
_Pragma("unroll") \
                        for (int kt = 0; kt < 4; ++kt) ap[(kk + 1) & 1][kt] = *(const bf16x8*)(sK + (kt * 16 + l15) * SKP + (kk + 1) * 32 + quad * 8); } \
                    __builtin_amdgcn_sched_barrier(0); \
_Pragma("unroll") \
                    for (int kt = 0; kt < 4; ++kt) st[kt] = mfma16(ap[kk & 1][kt], qf[qt][kk], st[kt]); \
                    __builtin_amdgcn_sched_barrier(0); \
                } \
                bf16x8 pf[2]; \
                attn_softmax<MODE>(st, tq[qt], key0, need_mask, rowsel, mrow[qt], lrow[qt], o[qt], pf, 0.f, sImp, lane); \
_Pragma("unroll") \
                for (int gq = 0; gq < 4; ++gq) { \
                    if (gq == 0) { \
_Pragma("unroll") \
                        for (int di = 0; di < 4; ++di) { const bf16x8 vv = *(const bf16x8*)(sVt + (di * 16 + l15) * SVP + quad * 8); vlo[0][di] = (bf16x4){vv[0], vv[1], vv[2], vv[3]}; vhi[0][di] = (bf16x4){vv[4], vv[5], vv[6], vv[7]}; } } \
                    if (gq + 1 < 4) { \
_Pragma("unroll") \
                        for (int di = 0; di < 4; ++di) { const bf16x8 vv = *(const bf16x8*)(sVt + ((((gq + 1) & 1) * 4 + di) * 16 + l15) * SVP + ((gq + 1) >> 1) * 32 + quad * 8); vlo[(gq + 1) & 1][di] = (bf16x4){vv[0], vv[1], vv[2], vv[3]}; vhi[(gq + 1) & 1][di] = (bf16x4){vv[4], vv[5], vv[6], vv[7]}; } } \
                    __builtin_amdgcn_sched_barrier(0); \
_Pragma("unroll") \
                    for (int di = 0; di < 4; ++di) { const int dt = (gq & 1) * 4 + di; \
                        const bf16x8 a = {vlo[gq & 1][di][0], vlo[gq & 1][di][1], vlo[gq & 1][di][2], vlo[gq & 1][di][3], vhi[gq & 1][di][0], vhi[gq & 1][di][1], vhi[gq & 1][di][2], vhi[gq & 1][di][3]}; \
                        o[qt][dt] = mfma16(a, pf[gq >> 1], o[qt][dt]); } \
                    __builtin_amdgcn_sched_barrier(0); \
                } \
            } \
        } \
 \
} while (0)
    if (DEEP) {
        for (int t0 = t_lo; t0 < t_hi; t0 += 2) {
            { const int t = t0; ATT_BODY(t, 0);
              if (t + 1 < t_hi) ATT_WRITE(kregB, vregB, smem + A_BUFSZ); __syncthreads(); if (t + 3 < t_hi) ATT_LOAD(kregB, vregB, t + 3); }
            if (t0 + 1 < t_hi) { const int t = t0 + 1; ATT_BODY(t, 1);
              if (t + 1 < t_hi) ATT_WRITE(kregA, vregA, smem); __syncthreads(); if (t + 3 < t_hi) ATT_LOAD(kregA, vregA, t + 3); }
        }
    } else {
        for (int t = t_lo; t < t_hi; ++t) {
            const int bs = (t - t_lo) & 1; ATT_BODY(t, bs);
            if (t + 1 < t_hi) ATT_WRITE(kregA, vregA, smem + (bs ^ 1) * A_BUFSZ); __syncthreads(); if (t + 2 < t_hi) ATT_LOAD(kregA, vregA, t + 2);
        }
    }
#undef ATT_BODY
#undef ATT_LOAD
#undef ATT_WRITE
}

template <int BR>
__device__ __forceinline__ void attn_acc(const f32x4 (&o)[2][8], const float (&lrow)[2], bool normalised, const float (&gate)[2], bf16_t* acc, int l15, int quad) {
#pragma unroll
    for (int qt = 0; qt < 2; ++qt) {
        const float f = gate[qt] * (normalised ? 1.0f : (lrow[qt] > 0.f ? 1.0f / lrow[qt] : 0.f));
#pragma unroll
        for (int dt = 0; dt < 8; ++dt) {
            bf16_t* ap = acc + (qt * 16 + l15) * 136 + dt * 16 + quad * 4;
            f32x4 v = o[qt][dt] * f;
            if (BR != 0) { const u32x2 old = *(const u32x2*)ap; v[0] += bflo(old.x); v[1] += bfhi(old.x); v[2] += bflo(old.y); v[3] += bfhi(old.y); }
            u32x2 wv; wv.x = cvt_pk_bf16(v[0], v[1]); wv.y = cvt_pk_bf16(v[2], v[3]); *(u32x2*)ap = wv;
        }
    }
}
template <int SKIPM>
__device__ __forceinline__ void attn_item(const Params& p, int bg, int qi, unsigned char* smem) {
    const int tid = get_tid(), lane = tid & 63, w = tid >> 6, l15 = lane & 15, quad = lane >> 4;
    const int b = bg >> 2, g = bg & 3, s0 = qi * 64, head = g * 4 + (l15 & 3), wtok0 = s0 + 8 * w, cur = qi;
    unsigned char* ws = p.ws;
    const bf16_t* proj = (const bf16_t*)(ws + WS_PROJ); bf16_t* obuf = (bf16_t*)(ws + WS_OBUF);
    float* sImp = (float*)(smem + A_IMP); unsigned long long* sSel = (unsigned long long*)(smem + A_SEL); bf16_t* acc = (bf16_t*)(smem + A_ACC + w * A_ACCW);
    TMR_BEGIN(4)
    const int tq[2] = {wtok0 + (l15 >> 2), wtok0 + 4 + (l15 >> 2)};
    bf16x8 qf[2][4];
#pragma unroll
    for (int qt = 0; qt < 2; ++qt)
#pragma unroll
        for (int kk = 0; kk < 4; ++kk) { const u32x4 raw = *(const u32x4*)(proj + (size_t)(b * SEQ + tq[qt]) * NSA_NP + Q0 + head * 128 + kk * 32 + quad * 8);
            u32x4 sc; sc.x = cvt_pk_bf16(bflo(raw.x) * ATT_C2, bfhi(raw.x) * ATT_C2); sc.y = cvt_pk_bf16(bflo(raw.y) * ATT_C2, bfhi(raw.y) * ATT_C2);
            sc.z = cvt_pk_bf16(bflo(raw.z) * ATT_C2, bfhi(raw.z) * ATT_C2); sc.w = cvt_pk_bf16(bflo(raw.w) * ATT_C2, bfhi(raw.w) * ATT_C2);
            qf[qt][kk] = *reinterpret_cast<bf16x8*>(&sc); }
    float gcmp[2], gsel[2], gwin[2];
#pragma unroll
    for (int qt = 0; qt < 2; ++qt) { const bf16_t* gp = proj + (size_t)(b * SEQ + tq[qt]) * NSA_NP + GL0 + head; gcmp[qt] = bf2f(gp[0]); gsel[qt] = bf2f(gp[16]); gwin[qt] = bf2f(gp[32]); }
    __syncthreads();
    for (int i = tid; i < 64 * 132; i += NTHR) sImp[i] = 0.f;
    float mrow[2], lrow[2]; f32x4 o[2][8];
    unsigned long long selm[2][2] = {{0ull, 0ull}, {0ull, 0ull}};
    const bf16_t* projb = proj + (size_t)b * SEQ * NSA_NP;
    {
        const bf16_t* kc = (const bf16_t*)(ws + WS_KCMP) + (size_t)bg * 512 * 128; const bf16_t* vct = (const bf16_t*)(ws + WS_VCMPT) + (size_t)bg * 128 * 512;
        const int nmax = (s0 + 32) / 16, nt = nmax / 64 + 1;
        mrow[0] = mrow[1] = -1e30f; lrow[0] = lrow[1] = 0.f;
#pragma unroll
        for (int qt = 0; qt < 2; ++qt)
#pragma unroll
            for (int dt = 0; dt < 8; ++dt) o[qt][dt] = (f32x4){0.f, 0.f, 0.f, 0.f};
        if (!(SKIPM & 1)) {
        TMR_BEGIN(0)
        attn_branch<0>(kc, 128, vct, 64, 512, 0, nt, qf, tq, mrow, lrow, o, selm, smem, wtok0, qi);
        TMR_END(0)
        TMR_BEGIN(1)
        attn_branch<1>(kc, 128, vct, 64, 512, 0, nt, qf, tq, mrow, lrow, o, selm, smem, wtok0, qi);
        TMR_END(1)
        }
    }
    __syncthreads();
#pragma unroll 1
    for (int i = 0; i < 8; ++i) {
        const int tl = w * 8 + i;
        unsigned key[2];
#pragma unroll
        for (int h = 0; h < 2; ++h) {
            const int k = lane + 64 * h; const float v = sImp[tl * 132 + k];
            const bool valid = k <= cur, forced = (k == 0) || (k == cur) || (k == cur - 1);
            key[h] = valid ? (forced ? 0xFFFFFFFFu : (__float_as_uint(fmaxf(v, 0.f)) + 1u)) : 0u;
        }
        unsigned prefix = 0u; int need = 16;
#pragma unroll 1
        for (int bit = 31; bit >= 0; --bit) {
            const unsigned mhi = bit == 31 ? 0u : (0xFFFFFFFFu << (bit + 1));
            const bool c0 = ((key[0] & mhi) == prefix) && ((key[0] >> bit) & 1u);
            const bool c1 = ((key[1] & mhi) == prefix) && ((key[1] >> bit) & 1u);
            const int cnt = __popcll(__ballot(c0)) + __popcll(__ballot(c1));
            if (cnt >= need) prefix |= (1u << bit); else need -= cnt;
        }
        const unsigned long long beq0 = __ballot(key[0] == prefix), beq1 = __ballot(key[1] == prefix);
        const unsigned long long lt = (1ull << lane) - 1ull;
        const int r0 = __popcll(beq0 & lt), r1 = __popcll(beq0) + __popcll(beq1 & lt);
        const bool s0 = (key[0] > prefix) || (key[0] == prefix && r0 < need);
        const bool s1 = (key[1] > prefix) || (key[1] == prefix && r1 < need);
        const unsigned long long b0 = __ballot(s0), b1 = __ballot(s1);
        if (lane == 0) { sSel[tl * 2] = b0; sSel[tl * 2 + 1] = b1; }
    }
    __syncthreads();
    attn_acc<0>(o, lrow, true, gcmp, acc, l15, quad);
    {
        mrow[0] = mrow[1] = -1e30f; lrow[0] = lrow[1] = 0.f;
#pragma unroll
        for (int qt = 0; qt < 2; ++qt)
#pragma unroll
            for (int dt = 0; dt < 8; ++dt) o[qt][dt] = (f32x4){0.f, 0.f, 0.f, 0.f};
        const int t_lo = qi - 8 > 0 ? qi - 8 : 0;
#if (ATT_REPEAT & 2)
        attn_branch<2>(projb + KW0 + g * 128, NSA_NP, (const bf16_t*)(ws + WS_VWT) + (size_t)bg * 128 * SEQ, 64, SEQ, t_lo, qi + 1, qf, tq, mrow, lrow, o, selm, smem, wtok0, qi);
        mrow[0] = mrow[1] = -1e30f; lrow[0] = lrow[1] = 0.f;
#pragma unroll
        for (int qt = 0; qt < 2; ++qt)
#pragma unroll
            for (int dt = 0; dt < 8; ++dt) o[qt][dt] = (f32x4){0.f, 0.f, 0.f, 0.f};
#endif
        TMR_BEGIN(2)
        if (!(SKIPM & 2))
        attn_branch<2>(projb + KW0 + g * 128, NSA_NP, (const bf16_t*)(ws + WS_VWT) + (size_t)bg * 128 * SEQ, 64, SEQ, t_lo, qi + 1, qf, tq, mrow, lrow, o, selm, smem, wtok0, qi);
        TMR_END(2)
        attn_acc<1>(o, lrow, false, gwin, acc, l15, quad);
    }
    {
        mrow[0] = mrow[1] = -1e30f; lrow[0] = lrow[1] = 0.f;
#pragma unroll
        for (int qt = 0; qt < 2; ++qt)
#pragma unroll
            for (int dt = 0; dt < 8; ++dt) o[qt][dt] = (f32x4){0.f, 0.f, 0.f, 0.f};
#if (ATT_REPEAT & 4)
        attn_branch<3>(projb + KS0 + g * 128, NSA_NP, (const bf16_t*)(ws + WS_VST) + (size_t)bg * 128 * SEQ, 64, SEQ, 0, cur + 1, qf, tq, mrow, lrow, o, selm, smem, wtok0, qi);
        mrow[0] = mrow[1] = -1e30f; lrow[0] = lrow[1] = 0.f;
#pragma unroll
        for (int qt = 0; qt < 2; ++qt)
#pragma unroll
            for (int dt = 0; dt < 8; ++dt) o[qt][dt] = (f32x4){0.f, 0.f, 0.f, 0.f};
#endif
        TMR_BEGIN(3)
        if (!(SKIPM & 4))
        attn_branch<3>(projb + KS0 + g * 128, NSA_NP, (const bf16_t*)(ws + WS_VST) + (size_t)bg * 128 * SEQ, 64, SEQ, 0, cur + 1, qf, tq, mrow, lrow, o, selm, smem, wtok0, qi);
        TMR_END(3)
        attn_acc<1>(o, lrow, false, gsel, acc, l15, quad);
    }
    asm volatile("s_waitcnt lgkmcnt(0)" ::: "memory");
#pragma unroll
    for (int i = 0; i < 8; ++i) {
        const int row = i * 4 + quad, c8 = l15 * 8, tok = wtok0 + 4 * (row >> 4) + ((row & 15) >> 2), hd = g * 4 + (row & 3);
        const u32x4 a = *(const u32x4*)(acc + row * 136 + c8);
        const u32x4 z = *(const u32x4*)(proj + (size_t)(b * SEQ + tok) * NSA_NP + Z0 + hd * 128 + c8);
        u32x4 r; r.x = cvt_pk_bf16(bflo(a.x) * bflo(z.x), bfhi(a.x) * bfhi(z.x)); r.y = cvt_pk_bf16(bflo(a.y) * bflo(z.y), bfhi(a.y) * bfhi(z.y));
        r.z = cvt_pk_bf16(bflo(a.z) * bflo(z.z), bfhi(a.z) * bfhi(z.z)); r.w = cvt_pk_bf16(bflo(a.w) * bflo(z.w), bfhi(a.w) * bfhi(z.w));
        *(u32x4*)(obuf + (size_t)(b * SEQ + tok) * DM + hd * 128 + c8) = r;
    }
    __syncthreads();
    TMR_END(4)
}
constexpr int H_G = 0;
constexpr int H_TOT = 16384;
constexpr int H_DEC = 18432;
constexpr int H_QB = 18944;
constexpr int H_KM = 27648;
constexpr int H_KBT = 36352;
constexpr int H_IT = 46592;
constexpr int H_ATT = 56832;
constexpr int H_O = 59392;
template <int PASS>
__device__ __forceinline__ void hgrn_item(const Params& p, int hl, int item, unsigned char* smem) {
    const int tid = get_tid(), lane = tid & 63, w = tid >> 6, l15 = lane & 15, quad = lane >> 4;
    const int bh = item >> 3, seg = item & 7, b = bh >> 4, h = bh & 15;
    unsigned char* ws = p.ws;
    const bf16_t* proj = (const bf16_t*)(ws + WS_PROJ); bf16_t* obuf = (bf16_t*)(ws + WS_OBUF);
    float* hseg = (float*)(ws + WS_HSEG);
    float* sTot = (float*)(smem + H_TOT); float* sDec = (float*)(smem + H_DEC);
    bf16_t* sQb = (bf16_t*)(smem + H_QB); bf16_t* sKm = (bf16_t*)(smem + H_KM); bf16_t* sKbT = (bf16_t*)(smem + H_KBT); bf16_t* sIT = (bf16_t*)(smem + H_IT);
    bf16_t* sAtt = (bf16_t*)(smem + H_ATT); float* sO = (float*)(smem + H_O);
    const int d = tid & 127, tqr = tid >> 7;
    const size_t tokbase = (size_t)b * SEQ + (size_t)seg * 1024;
    const bf16_t* pq = proj + tokbase * HG_NP + h * 128 + d;
    f32x4 S[8];
#pragma unroll
    for (int dt = 0; dt < 8; ++dt) S[dt] = (f32x4){0.f, 0.f, 0.f, 0.f};
    if (PASS == 1) {
        for (int sj = 0; sj < seg; ++sj) {
            const float* U = hseg + (size_t)(bh * 8 + sj) * HSEG_STRIDE; const float* Dv = U + 128 * 128;
#pragma unroll
            for (int dt = 0; dt < 8; ++dt)
#pragma unroll
                for (int j = 0; j < 4; ++j) { const int dd = dt * 16 + quad * 4 + j; S[dt][j] = S[dt][j] * Dv[dd] + U[dd * 128 + 16 * w + l15]; }
        }
    }
    float gtot = 0.f;
    const int gt = tid >> 4, gi8 = (tid & 15) * 8;
    f32x4 gw0 = {1.f, 1.f, 1.f, 1.f}, gw1 = gw0; u32x4 zreg = {0u, 0u, 0u, 0u};
    if (PASS == 1) { const float* gwp = p.hg_gn + hl * 128 + gi8; gw0 = *(const f32x4*)gwp; gw1 = *(const f32x4*)(gwp + 4);
        zreg = *(const u32x4*)(proj + (tokbase + gt) * HG_NP + 6144 + h * 128 + gi8); }
    bf16_t rg[8], ri[8], rq[8];
#pragma unroll
    for (int j = 0; j < 8; ++j) { const bf16_t* pc = pq + (size_t)(tqr * 8 + j) * HG_NP; rg[j] = pc[2048]; ri[j] = pc[4096]; rq[j] = PASS == 1 ? pc[0] : (bf16_t)0; }
#define HG_GNORM(CC) do { \
            { const int t = tid >> 4, i8c = (tid & 15) * 8; float v[8]; float ss = 0.f; \
              const f32x4 a0 = *(const f32x4*)(sO + t * 132 + i8c), a1 = *(const f32x4*)(sO + t * 132 + i8c + 4); \
_Pragma("unroll") \
              for (int j = 0; j < 4; ++j) { v[j] = a0[j]; v[4 + j] = a1[j]; } \
_Pragma("unroll") \
              for (int j = 0; j < 8; ++j) ss += v[j] * v[j]; \
              ss = row16_sum(ss); \
              const float rinv = rsqrtf(ss * (1.0f / 128.0f) + RMS_EPS); \
              const size_t tok = tokbase + (size_t)(CC) * 32 + t; \
              const u32x4 z = zreg; const f32x4 g0 = gw0, g1 = gw1; \
              v[0] *= rinv * g0[0] * bflo(z.x); v[1] *= rinv * g0[1] * bfhi(z.x); v[2] *= rinv * g0[2] * bflo(z.y); v[3] *= rinv * g0[3] * bfhi(z.y); \
              v[4] *= rinv * g1[0] * bflo(z.z); v[5] *= rinv * g1[1] * bfhi(z.z); v[6] *= rinv * g1[2] * bflo(z.w); v[7] *= rinv * g1[3] * bfhi(z.w); \
              *(bf16x8*)(obuf + tok * DM + h * 128 + i8c) = pack8f(v); } \
} while (0)
    u32x4 znext = zreg;
    for (int c = 0; c < 32; ++c) {
        float g8[8], q8[8], i8[8];
#pragma unroll
        for (int j = 0; j < 8; ++j) { g8[j] = bf2f(rg[j]); i8[j] = bf2f(ri[j]); q8[j] = PASS == 1 ? bf2f(rq[j]) : 0.f; }
        float cs[8]; cs[0] = g8[0];
#pragma unroll
        for (int j = 1; j < 8; ++j) cs[j] = cs[j - 1] + g8[j];
        sTot[tqr * 128 + d] = cs[7];
        __syncthreads();
        if (PASS == 1 && c > 0) { HG_GNORM(c - 1); zreg = znext; }
        float off = 0.f, bl = 0.f;
#pragma unroll
        for (int q = 0; q < 4; ++q) { const float tv = sTot[q * 128 + d]; bl += tv; if (q < tqr) off += tv; }
        { float kb[8], iv[8];
#pragma unroll
          for (int j = 0; j < 8; ++j) {
              const float bt = off + cs[j];
              const float kk = 1.0f - __expf(g8[j]);
              kb[j] = kk * __expf(bl - bt); iv[j] = i8[j];
              if (PASS == 1) {
                  const int t = tqr * 8 + j;
                  sQb[t * 136 + d] = (bf16_t)cvt_pk_bf16(q8[j] * __expf(bt), 0.f);
                  sKm[t * 136 + d] = (bf16_t)cvt_pk_bf16(kk * __expf(fminf(-bt, 80.f)), 0.f);
              }
          }
          *(bf16x8*)(sKbT + d * 40 + tqr * 8) = pack8f(kb);
          *(bf16x8*)(sIT + d * 40 + tqr * 8) = pack8f(iv); }
        if (tqr == 0) { sDec[d] = __expf(bl); gtot += bl; }
        __syncthreads();
        if (c + 1 < 32) {
#pragma unroll
            for (int j = 0; j < 8; ++j) { const bf16_t* pc = pq + (size_t)((c + 1) * 32 + tqr * 8 + j) * HG_NP; rg[j] = pc[2048]; ri[j] = pc[4096]; if (PASS == 1) rq[j] = pc[0]; }
        }
        if (PASS == 1 && c + 1 < 32) znext = *(const u32x4*)(proj + (tokbase + (c + 1) * 32 + gt) * HG_NP + 6144 + h * 128 + gi8);
        const bf16x8 ifr = *(const bf16x8*)(sIT + (16 * w + l15) * 40 + quad * 8);
        f32x4 oacc[2] = {{0.f, 0.f, 0.f, 0.f}, {0.f, 0.f, 0.f, 0.f}};
        if (PASS == 1) {
            if (w < 4) {
                const int rt = w >> 1, ct = w & 1; f32x4 a4 = {0.f, 0.f, 0.f, 0.f};
#pragma unroll
                for (int kk = 0; kk < 4; ++kk) {
                    const bf16x8 a = *(const bf16x8*)(sQb + (rt * 16 + l15) * 136 + kk * 32 + quad * 8);
                    const bf16x8 bb = *(const bf16x8*)(sKm + (ct * 16 + l15) * 136 + kk * 32 + quad * 8);
                    a4 = mfma16(a, bb, a4);
                }
#pragma unroll
                for (int j = 0; j < 4; ++j) { const int t = rt * 16 + quad * 4 + j, s = ct * 16 + l15; sAtt[t * 40 + s] = (bf16_t)cvt_pk_bf16(s <= t ? a4[j] : 0.f, 0.f); }
            }
#pragma unroll
            for (int kk = 0; kk < 4; ++kk) {
                const bf16x8 bs = pack44(S[2 * kk], S[2 * kk + 1]);
#pragma unroll
                for (int rt = 0; rt < 2; ++rt) {
                    const bf16_t* qp = sQb + (rt * 16 + l15) * 136 + kk * 32 + quad * 4;
                    const bf16x4 lo = *(const bf16x4*)qp, hi = *(const bf16x4*)(qp + 16);
                    const bf16x8 a = {lo[0], lo[1], lo[2], lo[3], hi[0], hi[1], hi[2], hi[3]};
                    oacc[rt] = mfma16(a, bs, oacc[rt]);
                }
            }
        }
#pragma unroll
        for (int dt = 0; dt < 8; ++dt) {
            const f32x4 dc = *(const f32x4*)(sDec + dt * 16 + quad * 4);
            const bf16x8 a = *(const bf16x8*)(sKbT + (dt * 16 + l15) * 40 + quad * 8);
            S[dt] = mfma16(a, ifr, S[dt] * dc);
        }
        if (PASS == 1) {
            __syncthreads();
#pragma unroll
            for (int rt = 0; rt < 2; ++rt) { const bf16x8 a = *(const bf16x8*)(sAtt + (rt * 16 + l15) * 40 + quad * 8); oacc[rt] = mfma16(a, ifr, oacc[rt]); }
#pragma unroll
            for (int rt = 0; rt < 2; ++rt)
#pragma unroll
                for (int j = 0; j < 4; ++j) sO[(rt * 16 + quad * 4 + j) * 132 + 16 * w + l15] = oacc[rt][j];
        }
    }
    if (PASS == 1) { __syncthreads(); HG_GNORM(31); }
#undef HG_GNORM
    if (PASS == 0) {
        float* U = hseg + (size_t)(bh * 8 + seg) * HSEG_STRIDE;
#pragma unroll
        for (int dt = 0; dt < 8; ++dt)
#pragma unroll
            for (int j = 0; j < 4; ++j) U[(dt * 16 + quad * 4 + j) * 128 + 16 * w + l15] = S[dt][j];
        if (tqr == 0) U[128 * 128 + d] = __expf(gtot);
    }
    __syncthreads();
}

#define XB_TMO      128
#define XB_XCNT(j)  (256  + 64 * (j))
#define XB_XSUB(j)  (1280 + 64 * (j))
#define XB_XGEN(j)  (2304 + 64 * (j))
#define XB_TOP      3328
#define XB_TOPGEN   3392
#define XCD_BAR_WORDS 3456
#define XB_SPIN_CAP (1u << 18)
#define XLAS __attribute__((address_space(3)))

__device__ __forceinline__ unsigned xb_ld(unsigned* p)              { return __hip_atomic_load(p, __ATOMIC_RELAXED, __HIP_MEMORY_SCOPE_AGENT); }
__device__ __forceinline__ unsigned xb_add(unsigned* p, unsigned v) { return __hip_atomic_fetch_add(p, v, __ATOMIC_RELAXED, __HIP_MEMORY_SCOPE_AGENT); }
__device__ __forceinline__ unsigned xb_xcc_id() { return (unsigned)__builtin_amdgcn_s_getreg((3 << 11) | 20) & 0xFu; }
#define XB_SPIN(cond, bar) do { unsigned _sp = 0; while (cond) { __builtin_amdgcn_s_sleep(1); \
    if ((++_sp & 255u) == 0u) { if (xb_ld(&(bar)[XB_TMO])) break; if (_sp > XB_SPIN_CAP) { atomicAdd(&(bar)[XB_TMO], 1u); break; } } } } while (0)

struct XcdBarrier {
    unsigned* bar; unsigned x;
    volatile XLAS unsigned* st;
};

__device__ __forceinline__ XcdBarrier xcd_barrier_post(unsigned* bar, volatile XLAS unsigned* st) {
    XcdBarrier b; b.bar = bar; b.x = xb_xcc_id(); b.st = st;
    if (threadIdx.x == 0) (void)xb_add(&bar[XB_XCNT(b.x)], 1u);
    return b;
}
__device__ __forceinline__ void xcd_barrier_complete(unsigned* bar, unsigned x, unsigned& nloc, unsigned& nx) {
    const unsigned G = gridDim.x * gridDim.y * gridDim.z;
    unsigned sum, cnt, mine, sp = 0u;
    for (;;) {
        sum = 0u; cnt = 0u; mine = 0u;
#pragma unroll
        for (unsigned j = 0; j < 16; ++j) { const unsigned c = xb_ld(&bar[XB_XCNT(j)]); sum += c; cnt += (c > 0u) ? 1u : 0u; mine = (j == x) ? c : mine; }
        if (sum == G) break;
        __builtin_amdgcn_s_sleep(1);
        if ((++sp & 255u) == 0u) { if (xb_ld(&bar[XB_TMO])) break; if (sp > XB_SPIN_CAP) { atomicAdd(&bar[XB_TMO], 1u); break; } }
    }
    nloc = mine > 0u ? mine : 1u; nx = cnt > 0u ? cnt : 1u;
}

__device__ __forceinline__ void xcd_barrier(const XcdBarrier& b) {
    asm volatile("s_waitcnt vmcnt(0)" ::: "memory");
    __syncthreads();
    if (threadIdx.x == 0) {
        unsigned* bar = b.bar;
        __builtin_amdgcn_s_waitcnt(0);
        unsigned nloc = b.st[0], nx = b.st[1];
        if (nloc == 0u) { xcd_barrier_complete(bar, b.x, nloc, nx); b.st[0] = nloc; b.st[1] = nx; }
        const unsigned old = xb_add(&bar[XB_XSUB(b.x)], 1u);
        const unsigned gen = old / nloc;
        if (old + 1u == (gen + 1u) * nloc) {
            __builtin_amdgcn_fence(__ATOMIC_RELEASE, "agent");
            asm volatile("s_waitcnt vmcnt(0)" ::: "memory");
            const unsigned og = xb_add(&bar[XB_TOP], 1u);
            const unsigned tg = og / nx;
            if (og + 1u == (tg + 1u) * nx) xb_add(&bar[XB_TOPGEN], 1u);
            else XB_SPIN(xb_ld(&bar[XB_TOPGEN]) == tg, bar);
            __builtin_amdgcn_fence(__ATOMIC_ACQUIRE, "agent");
            xb_add(&bar[XB_XGEN(b.x)], 1u);
            asm volatile("s_waitcnt vmcnt(0)" ::: "memory");
        } else {
            XB_SPIN(xb_ld(&bar[XB_XGEN(b.x)]) == gen, bar);
            __builtin_amdgcn_fence(__ATOMIC_ACQUIRE, "agent");
            asm volatile("s_waitcnt vmcnt(0)" ::: "memory");
        }
    }
    __syncthreads();
}

#ifndef USE_XCD_BARRIER
#define USE_XCD_BARRIER 1
#endif
#ifndef ATT_DYNAMIC
#define ATT_DYNAMIC 0
#endif

#ifndef DEBUG_CENSUS
#define DEBUG_CENSUS 0
#endif
#if DEBUG_CENSUS
__device__ __forceinline__ void scan_bf16(const bf16_t* ptr, size_t n, int code, int* flag) {
    bool bad = false; const size_t st = (size_t)gridDim.x * NTHR;
    for (size_t i = (size_t)blockIdx.x * NTHR + get_tid(); i < n; i += st) bad |= ((ptr[i] & 0x7f80) == 0x7f80);
    if (bad) atomicMin(flag, code);
}
__device__ __forceinline__ void scan_f32(const float* ptr, size_t n, int code, int* flag) {
    bool bad = false; const size_t st = (size_t)gridDim.x * NTHR;
    for (size_t i = (size_t)blockIdx.x * NTHR + get_tid(); i < n; i += st) bad |= ((__float_as_uint(ptr[i]) & 0x7f800000u) == 0x7f800000u);
    if (bad) atomicMin(flag, code);
}
__device__ __noinline__ void census_unused(); __device__ __forceinline__ void census(const Params& p, int ph) {
    unsigned char* ws = p.ws; int* flag = (int*)(ws + WS_CBIAS + 2048);
    const int layer = (ph - 1) >> 2, sub = (ph - 1) & 3; const bool nsa = (layer & 1) == 0;
    if (ph == 0) { scan_bf16((bf16_t*)(ws + WS_XB), (size_t)NTOK * DM, 0, flag); scan_bf16((bf16_t*)(ws + WS_WIN), (size_t)NSA_NP * DM, 1, flag);
        scan_f32((float*)(ws + WS_ROPE), (size_t)NTOK * 32, 2, flag); scan_f32((float*)(ws + WS_CBIAS), 512, 3, flag); scan_f32((float*)(ws + WS_LB), 4096, 4, flag); scan_f32((float*)(ws + WS_SSQ), NTOK, 5, flag);
        scan_bf16((bf16_t*)(ws + WS_W1T), (size_t)4 * 128 * 4096, 6, flag); scan_bf16((bf16_t*)(ws + WS_W2T), (size_t)4 * 128 * 128, 7, flag); }
    else if (ph == 17) {}
    else if (sub == 0) scan_bf16((bf16_t*)(ws + WS_PROJ), (size_t)NTOK * (nsa ? NSA_NP : HG_NP), 8 + 8 * layer + 0, flag);
    else if (sub == 1) { if (nsa) { scan_bf16((bf16_t*)(ws + WS_KCMP), (size_t)8 * 512 * 128, 8 + 8 * layer + 1, flag); scan_bf16((bf16_t*)(ws + WS_VCMPT), (size_t)8 * 512 * 128, 8 + 8 * layer + 2, flag);
                                   scan_bf16((bf16_t*)(ws + WS_VST), (size_t)8 * 128 * SEQ, 8 + 8 * layer + 3, flag); scan_bf16((bf16_t*)(ws + WS_VWT), (size_t)8 * 128 * SEQ, 8 + 8 * layer + 3, flag); }
                         else { for (int it = 0; it < 256; ++it) if ((it & 7) != 7) scan_f32((float*)(ws + WS_HSEG) + (size_t)it * HSEG_STRIDE, HSEG_STRIDE, 8 + 8 * layer + 1, flag); }
                         scan_bf16((bf16_t*)(ws + WS_WOUT), (size_t)DM * DM, 8 + 8 * layer + 4, flag); scan_bf16((bf16_t*)(ws + WS_WIN), (size_t)DM * NSA_NP, 8 + 8 * layer + 4, flag); }
    else if (sub == 2) scan_bf16((bf16_t*)(ws + WS_OBUF), (size_t)NTOK * DM, 8 + 8 * layer + 5, flag);
    else { scan_f32(p.out, (size_t)NTOK * DM, 8 + 8 * layer + 6, flag); scan_f32((float*)(ws + WS_SSQ) + (size_t)(layer + 1) * NTOK, NTOK, 8 + 8 * layer + 7, flag); }
}
#endif
constexpr int N_PHASES = 18;
__global__ void __launch_bounds__(NTHR, 2) fwd_kernel(Params p_in) {
    extern __shared__ __attribute__((aligned(16))) unsigned char smem[];
    const int tid = get_tid();
    float* tile = (float*)smem;
    XcdBarrier xbar; xbar.bar = (unsigned*)(p_in.ws + WS_BAR); xbar.x = 0; xbar.st = (volatile XLAS unsigned*)(smem + LDS_BYTES - 16);
    if (p_in.coop) {
        if (threadIdx.x < 4) ((XLAS unsigned*)(smem + LDS_BYTES - 16))[threadIdx.x] = 0u;
        __syncthreads();
        xbar = xcd_barrier_post((unsigned*)(p_in.ws + WS_BAR), (volatile XLAS unsigned*)(smem + LDS_BYTES - 16));
    }
    const Params& p0 = p_in;
#ifndef REPEAT_MASK
#define REPEAT_MASK 0
#endif
    int rep = 0;
    for (int ph = p0.ph_lo; ph < p0.ph_hi;) {
        Params p = p0;
        unsigned char* ws = p.ws; int blk = blockIdx.x, nblk = gridDim.x;
        asm volatile("" : "+s"(ws), "+s"(blk), "+s"(nblk));
        p.ws = ws;
        bf16_t* Win = (bf16_t*)(ws + WS_WIN); bf16_t* Wout = (bf16_t*)(ws + WS_WOUT);
        bf16_t* xb = (bf16_t*)(ws + WS_XB); bf16_t* proj = (bf16_t*)(ws + WS_PROJ); bf16_t* obuf = (bf16_t*)(ws + WS_OBUF);
        float* ssq = (float*)(ws + WS_SSQ);
        if (ph == 0) phase_prep(p, smem);
#if DEBUG_TIMER
        else if (ph == 17) { const size_t st = (size_t)nblk * NTHR; for (size_t i = (size_t)blk * NTHR + tid; i < (size_t)NTOK * DM; i += st) p.out[i] = 0.f;
            if (blk == 0 && tid == 0) { const unsigned long long c = *(unsigned long long*)(ws + WS_CBIAS + 2048 + 16); p.out[0] = (float)c * 0.01f * 100.f; } }
#endif
#if DEBUG_CENSUS
        else if (ph == 17) { const size_t st = (size_t)nblk * NTHR; for (size_t i = (size_t)blk * NTHR + tid; i < (size_t)NTOK * DM; i += st) p.out[i] = 0.f;
            if (blk == 0 && tid == 0) { int c = *(int*)(ws + WS_CBIAS + 2048); if (c > 80) c = 80; p.out[0] = (10.f + (float)c) * 1000.f; } }
#endif
        else if (ph == 17) {
            const int lane = tid & 63, wave = tid >> 6;
            for (int row = blk * 8 + wave; row < NTOK; row += nblk * 8) {
                const float rs = rsqrtf(ssq[4 * NTOK + row] * (1.0f / 2048.0f) + RMS_EPS); float* xr = p.out + (size_t)row * DM;
#pragma unroll
                for (int i = 0; i < 8; ++i) { const int c = (i * 64 + lane) * 4; f32x4 v = *(const f32x4*)(xr + c); const f32x4 wv = *(const f32x4*)(p.fnorm_w + c); v = v * rs * wv;
#if SANITIZE
                    for (int e = 0; e < 4; ++e) if (!(fabsf(v[e]) < 1e30f)) v[e] = 0.f;
#endif
                    *(f32x4*)(xr + c) = v; }
            }
        } else {
            const int layer = (ph - 1) >> 2, sub = (ph - 1) & 3, j = layer >> 1; const bool nsa = (layer & 1) == 0;
            if (sub == 0) {
#if (REPEAT_MASK & 64)
                if (rep == 0) { pg8::Gemm g{xb, Win, NTOK, nsa ? NSA_NP : HG_NP, DM}; pg8::StaticOrder S; S.init(NTOK, nsa ? NSA_NP : HG_NP, nblk, blk);
                    EpiPlain E{proj, nsa ? NSA_NP : HG_NP};
                    pg8::gemm_phase<EpiPlain, pg8::StaticOrder, false>((PG8_LAS unsigned char*)smem, g, S, E, nullptr); }
                else
#endif
                if (nsa) { pg8::Gemm g{xb, Win, NTOK, NSA_NP, DM}; pg8::StaticOrder S; S.init(NTOK, NSA_NP, nblk, blk);
                    EpiNsaIn E{proj, ssq + (size_t)layer * NTOK, (const float*)(ws + WS_ROPE)};
                    pg8::gemm_phase<EpiNsaIn, pg8::StaticOrder, false>((PG8_LAS unsigned char*)smem, g, S, E, nullptr);
                    const int rem = ((NTOK / 256) * (NSA_NP / 256)) % nblk;
                    if (rem != 0 && blk >= rem) {
                        tconv<0>(p.nsa_w_out + (size_t)j * DM * DM, DM, DM, Wout, DM, DM, nullptr, tile, blk - rem, nblk - rem);
                        tconv<0>(p.hg_w_in + (size_t)j * DM * HG_NP, HG_NP, HG_NP, (bf16_t*)(ws + WS_WIN2), DM, HG_NP, p.norm_w + (size_t)(layer + 1) * DM, tile, blk - rem, nblk - rem);
                    } }
                else { pg8::Gemm g{xb, (bf16_t*)(ws + WS_WIN2), NTOK, HG_NP, DM}; pg8::StaticOrder S; S.init(NTOK, HG_NP, nblk, blk);
                    EpiHgIn E{proj, ssq + (size_t)layer * NTOK, (const float*)(ws + WS_LB) + j * 2048};
                    pg8::gemm_phase<EpiHgIn, pg8::StaticOrder, false>((PG8_LAS unsigned char*)smem, g, S, E, nullptr); }
            } else if (sub == 1) {
                if (nsa) {
                    for (int it = blk; it < 256; it += nblk) compress_item(p, j, it, smem);
                    for (int it = blk; it < 2048; it += nblk) vtrans_item(p, it, smem);
                    if (((NTOK / 256) * (NSA_NP / 256)) % nblk == 0) {
                        tconv<0>(p.nsa_w_out + (size_t)j * DM * DM, DM, DM, Wout, DM, DM, nullptr, tile, blk, nblk);
                        tconv<0>(p.hg_w_in + (size_t)j * DM * HG_NP, HG_NP, HG_NP, (bf16_t*)(ws + WS_WIN2), DM, HG_NP, p.norm_w + (size_t)(layer + 1) * DM, tile, blk, nblk);
                    }
                } else {
                    for (int it = blk; it < 256; it += nblk) if ((it & 7) != 7) hgrn_item<0>(p, j, it, smem);
                    tconv<0>(p.hg_w_out + (size_t)j * DM * DM, DM, DM, Wout, DM, DM, nullptr, tile, blk, nblk);
                    if (layer + 1 < 4) tconv<1>(p.nsa_w_in + (size_t)(j + 1) * DM * NSA_IN, NSA_IN, NSA_IN, Win, DM, NSA_NP, p.norm_w + (size_t)(layer + 1) * DM, tile, blk, nblk);
                }
            } else if (sub == 2) {
                if (nsa) {
#if ATT_DYNAMIC
                    {
                        unsigned* qhead = (unsigned*)(ws + WS_CBIAS + 2048 + 64) + j; volatile XLAS unsigned* qslot = (volatile XLAS unsigned*)(smem + LDS_BYTES - 32);
                        for (;;) {
                            __syncthreads();
                            if (threadIdx.x == 0) qslot[0] = atomicAdd(qhead, 1u);
                            __syncthreads();
                            const unsigned idx = qslot[0];
                            if (idx >= 1024u) break;
                            attn_item<0>(p, (int)(idx & 7u), 127 - (int)(idx >> 3), smem);
                        }
                    }
#else
                    for (int it = blk; it < 1024; it += nblk) { const int slot = it & 255, rnd = it >> 8, bg = slot & 7, jj = slot >> 3;
                        const int qi = rnd == 0 ? 127 - jj : (rnd == 1 ? 64 + jj : (rnd == 2 ? 63 - jj : jj));
#ifdef ATT_SKELETON_FIRST
                        attn_item<ATT_SKELETON_FIRST>(p, bg, qi, smem);
#endif
                        attn_item<0>(p, bg, qi, smem); }
#endif
                } else {
                    for (int it = blk; it < 256; it += nblk) hgrn_item<1>(p, j, it, smem);
                }
            } else {
                pg8::Gemm g{obuf, Wout, NTOK, DM, DM}; pg8::StaticOrder S; S.init(NTOK, DM, nblk, blk);
                EpiOut E{layer == 0 ? p.x : (const float*)p.out, p.out, xb, ssq + (size_t)(layer + 1) * NTOK};
                pg8::gemm_phase<EpiOut, pg8::StaticOrder, false>((PG8_LAS unsigned char*)smem, g, S, E, nullptr);
            }
        }
#if DEBUG_CENSUS
        if (ph != 17) census(p, ph);
#endif
        { const int sub_ = (ph - 1) & 3, nsa_ = ((((ph - 1) >> 2) & 1) == 0);
          const bool again = REPEAT_MASK != 0 && rep == 0 && ph >= 1 && ph <= 16 && ((sub_ == 0 && nsa_ && (REPEAT_MASK & 1)) || (sub_ == 0 && !nsa_ && (REPEAT_MASK & 2)) || (sub_ == 2 && nsa_ && (REPEAT_MASK & 4)) || (sub_ == 2 && !nsa_ && (REPEAT_MASK & 8)) || (sub_ == 1 && nsa_ && (REPEAT_MASK & 16)) || (sub_ == 1 && !nsa_ && (REPEAT_MASK & 32)) || (sub_ == 0 && (REPEAT_MASK & 64)));
          if (again) rep = 1; else { rep = 0; ++ph; } }
        if (ph < p0.ph_hi) { if (p0.coop) {
#if USE_XCD_BARRIER
            if (ph == 1) cg::this_grid().sync(); else xcd_barrier(xbar);
#else
            cg::this_grid().sync();
#endif
        } }
    }
}

extern "C" void kernel_launch(void* const* d_in, const int* in_sizes, int n_in, void* d_out, int out_size, void* d_ws, size_t ws_size, hipStream_t stream) {
    static int grid = 0;
    if (grid == 0) {
        if (ws_size < WS_END2) { fprintf(stderr, "kernel_launch: workspace too small: %zu < %zu\n", ws_size, (size_t)WS_END2); grid = -1; return; }
        int dev = 0, cus = 0, per_cu = 0;
        hipGetDevice(&dev); hipDeviceGetAttribute(&cus, hipDeviceAttributeMultiprocessorCount, dev);
        if (hipFuncSetAttribute((const void*)fwd_kernel, hipFuncAttributeMaxDynamicSharedMemorySize, LDS_BYTES) != hipSuccess) { fprintf(stderr, "kernel_launch: hipFuncSetAttribute failed\n"); grid = -1; return; }
        if (hipOccupancyMaxActiveBlocksPerMultiprocessor(&per_cu, (const void*)fwd_kernel, NTHR, LDS_BYTES) != hipSuccess || per_cu < 1) { fprintf(stderr, "kernel_launch: occupancy query says %d\n", per_cu); per_cu = 1; }
        (void)hipGetLastError();
        grid = cus * 1;
    }
    if (grid < 0) return;
    Params p{};
    p.x = (const float*)d_in[0]; p.pos = (const int*)d_in[1]; p.norm_w = (const float*)d_in[2]; p.fnorm_w = (const float*)d_in[3];
    p.nsa_w_in = (const float*)d_in[4]; p.ck_pos = (const float*)d_in[5]; p.ck_w1 = (const float*)d_in[6]; p.ck_w2 = (const float*)d_in[7];
    p.cv_pos = (const float*)d_in[8]; p.cv_w1 = (const float*)d_in[9]; p.cv_w2 = (const float*)d_in[10]; p.nsa_w_out = (const float*)d_in[11];
    p.hg_w_in = (const float*)d_in[12]; p.hg_lb = (const float*)d_in[13]; p.hg_gn = (const float*)d_in[14]; p.hg_w_out = (const float*)d_in[15];
    p.out = (float*)d_out; p.ws = (unsigned char*)d_ws;
#if DEBUG_CENSUS
    hipMemsetAsync((unsigned char*)d_ws + WS_CBIAS + 2048, 0x7f, 4, stream);
#endif
#if DEBUG_TIMER
    hipMemsetAsync((unsigned char*)d_ws + WS_CBIAS + 2048 + 16, 0, 8, stream);
#endif
#if ONE_LAUNCH
    hipMemsetAsync((unsigned char*)d_ws + WS_BAR, 0, 16384, stream);
    p.ph_lo = 0; p.ph_hi = N_PHASES; p.coop = 1; p.pad = 0;
    void* args[] = {&p};
    hipError_t e = hipLaunchCooperativeKernel((const void*)fwd_kernel, dim3(grid), dim3(NTHR), args, LDS_BYTES, stream);
    if (e != hipSuccess) fprintf(stderr, "cooperative launch failed: %s (grid %d)\n", hipGetErrorString(e), grid);
#else
    for (int ph = 0; ph < N_PHASES; ++ph) {
#ifdef DBG_LAST_PHASE
        if (ph > DBG_LAST_PHASE && ph != 17) continue;
#endif
        p.ph_lo = ph; p.ph_hi = ph + 1; p.coop = 0; p.pad = 0;
        hipLaunchKernelGGL(fwd_kernel, dim3(grid), dim3(NTHR), LDS_BYTES, stream, p);
    }
#endif
}
```

```cpp
#define ONE_LAUNCH 1
#include <hip/hip_runtime.h>
#include <hip/hip_cooperative_groups.h>
#include <cstdio>
namespace cg = cooperative_groups;
__device__ __forceinline__ int get_tid() { int t = threadIdx.x; asm volatile("" : "+v"(t)); return t; }
#ifndef PG8_WGM
#define PG8_WGM 4
#endif
#ifndef ONE_LAUNCH
#define ONE_LAUNCH 0
#endif
#ifndef SANITIZE
#define SANITIZE 0
#endif
namespace pg8 {
#define PG8_LAS __attribute__((address_space(3)))
typedef unsigned short bf16_t;
typedef short bf16x8 __attribute__((ext_vector_type(8)));
typedef float f32x4 __attribute__((ext_vector_type(4)));
typedef unsigned u32x4 __attribute__((ext_vector_type(4)));
constexpr int BM = 256, BK = 64, HALF = 128, HTB = HALF * BK * 2  , STAGE_BYTES = 8 * HTB, NXCD = 8, WGM = PG8_WGM;

__host__ __device__ __forceinline__ int lds_byte(int r, int c) { const int st = (r >> 4) * 2 + (c >> 5), rr = r & 15, cc = c & 31, ob = rr * 64 + cc * 2; return st * 1024 + (ob ^ (((ob >> 9) & 1) << 5)); }
__host__ __device__ __forceinline__ void stage_rc(int b, int& R, int& C) { const int st = b / 1024, sb = b % 1024, swz = sb ^ (((sb >> 9) & 1) << 5); R = (st >> 1) * 16 + swz / 64; C = (st & 1) * 32 + (swz % 64) / 2; }
__host__ __device__ __forceinline__ int perm32(int rho) { const int n = rho >> 4, i = rho & 15; return 8 * (i >> 2) + 4 * n + (i & 3); }

struct Unit { int pm, pn; };
struct Gemm { const bf16_t* A; const bf16_t* Bt; int M, N, K; };

struct StaticOrder {
    int nM, nN, nwg, G, c;
    __host__ __device__ void init(int M, int N, int G_, int c_) { nM = M / BM; nN = N / BM; nwg = nM * nN; G = G_; c = c_; }
    __host__ __device__ bool next(int i, Unit& u) const {
        const long L = (long)i * G + c; if (L >= nwg) return false;
        int wgid = (int)L; { const int q = nwg / NXCD, r = nwg % NXCD, xcd = wgid % NXCD, off = wgid / NXCD; wgid = (xcd < r ? xcd * (q + 1) : r * (q + 1) + (xcd - r) * q) + off; }
        const int nig = WGM * nN, gid = wgid / nig, fm = gid * WGM, gsz = (nM - fm) < WGM ? (nM - fm) : WGM;
        u.pm = fm + ((wgid % nig) % gsz); u.pn = (wgid % nig) / gsz; return true;
    }
    __device__ __forceinline__ void a_ready(const Unit&) const {}
    __device__ __forceinline__ void done(const Unit&) const {}
};
__device__ __forceinline__ unsigned cvt_pk_bf16(float lo, float hi) { unsigned r; asm volatile("v_cvt_pk_bf16_f32 %0, %1, %2" : "=v"(r) : "v"(lo), "v"(hi)); return r; }
typedef float f32x2 __attribute__((ext_vector_type(2)));
template <class Epi, class Sched, bool STAMP = false>
__device__ __forceinline__ void gemm_phase(PG8_LAS unsigned char* lds, const Gemm g, const Sched& S, const Epi& E, unsigned long long* stamps) {
    const int tid = get_tid(), wid = __builtin_amdgcn_readfirstlane(tid >> 6), lane = tid & 63, wr = wid >> 2, wc = wid & 3, fr = lane & 15, fq = lane >> 4;
    const int K = g.K, nt = K / BK;
    int ts_lo = 0, ts_hi = 0, nts = 0; const unsigned long long rt_entry = STAMP ? (unsigned long long)wall_clock64() : 0ull;
#define PG8_STAMP() do { if (STAMP && wid == 0 && nts < 64) { const unsigned long long _c = (unsigned long long)clock64(); \
        ts_lo = (lane == nts) ? (int)(unsigned)_c : ts_lo; ts_hi = (lane == nts) ? (int)(unsigned)(_c >> 32) : ts_hi; ++nts; } } while (0)
    PG8_STAMP();
    unsigned voffA[2], voffB[2];
#pragma unroll
    for (int i = 0; i < 2; ++i) { int R, C; stage_rc(tid * 16 + i * 8192, R, C); const int Rb = Epi::PERM ? ((R & ~31) + perm32(R & 31)) : R;
        voffA[i] = (unsigned)(R * K + C) * 2u; voffB[i] = (unsigned)(Rb * K + C) * 2u; }
    const size_t kstep = (size_t)(BK * 2);
    const size_t hstep = (size_t)HALF * K * 2;
    const size_t tstep = 2 * hstep;
    const unsigned ldsw = (unsigned)wid * 1024u;
    const int aoff = lds_byte(wr * 64 + fr, fq * 8), boff = lds_byte(wc * 32 + fr, fq * 8);
#define PG8_SA(b, h) (((b) * 2 + (h)) * HTB)
#define PG8_SB(b, h) ((4 + (b) * 2 + (h)) * HTB)
#define PG8_STAGE(bufoff, gbase, voff) do { _Pragma("unroll") for (int _i = 0; _i < 2; ++_i) \
        __builtin_amdgcn_global_load_lds((const unsigned*)((const char*)(gbase) + (voff)[_i]), (PG8_LAS unsigned*)(lds + (bufoff) + ldsw + _i * 8192), 16, 0, 0); } while (0)
#define PG8_LDA(dst, b, h) do { _Pragma("unroll") for (int m = 0; m < 4; ++m) _Pragma("unroll") for (int k = 0; k < 2; ++k) dst[m][k] = *(const PG8_LAS bf16x8*)(lds + PG8_SA(b, h) + aoff + m * 2048 + k * 1024); } while (0)
#define PG8_LDB(dst, b, h) do { _Pragma("unroll") for (int n = 0; n < 2; ++n) _Pragma("unroll") for (int k = 0; k < 2; ++k) dst[n][k] = *(const PG8_LAS bf16x8*)(lds + PG8_SB(b, h) + boff + n * 2048 + k * 1024); } while (0)
#define PG8_MMA(ai, bj, At, Bt) do { __builtin_amdgcn_s_setprio(1); _Pragma("unroll") for (int m = 0; m < 4; ++m) _Pragma("unroll") for (int n = 0; n < 2; ++n) _Pragma("unroll") for (int k = 0; k < 2; ++k) \
        acc[ai][bj][m][n] = __builtin_amdgcn_mfma_f32_16x16x32_bf16(Bt[n][k], At[m][k], acc[ai][bj][m][n], 0, 0, 0); __builtin_amdgcn_s_setprio(0); } while (0)
#define PG8_WAIT_V(n) asm volatile("s_waitcnt vmcnt(" #n ")" ::: "memory")
#define PG8_WAIT_L(n) asm volatile("s_waitcnt lgkmcnt(" #n ")" ::: "memory")
#define PG8_BAR __builtin_amdgcn_s_barrier()
#define PG8_SCHED __builtin_amdgcn_sched_barrier(0)
    Unit cur, nxt; int ui = 0;
    if (!S.next(0, cur)) return;
    f32x4 acc[2][2][4][2];
#pragma unroll
    for (int a = 0; a < 2; ++a)
#pragma unroll
        for (int b = 0; b < 2; ++b)
#pragma unroll
            for (int m = 0; m < 4; ++m)
#pragma unroll
                for (int n = 0; n < 2; ++n) acc[a][b][m][n] = (f32x4){0.f, 0.f, 0.f, 0.f};
    bf16x8 At[4][2], B0[2][2], B1[2][2];
    const char* cA = (const char*)g.A + (size_t)cur.pm * tstep; const char* cB = (const char*)g.Bt + (size_t)cur.pn * tstep;
    S.a_ready(cur);
    PG8_STAGE(PG8_SB(0, 0), cB, voffB); PG8_STAGE(PG8_SA(0, 0), cA, voffA); PG8_STAGE(PG8_SB(0, 1), cB + hstep, voffB); PG8_STAGE(PG8_SA(0, 1), cA + hstep, voffA);
    if (wr == 1) PG8_BAR;
    PG8_WAIT_V(4); PG8_BAR;
    PG8_STAGE(PG8_SB(1, 0), cB + kstep, voffB); PG8_STAGE(PG8_SA(1, 0), cA + kstep, voffA); PG8_STAGE(PG8_SB(1, 1), cB + hstep + kstep, voffB);
    PG8_WAIT_V(6); PG8_BAR;
    PG8_STAMP();
    for (;;) {
        const bool has_next = S.next(ui + 1, nxt);
        const char* nA = has_next ? (const char*)g.A + (size_t)nxt.pm * tstep : cA; const char* nB = has_next ? (const char*)g.Bt + (size_t)nxt.pn * tstep : cB;
        for (int t = 0; t < nt; t += 2) {
            const bool last = (t == nt - 2);
            const char* a1 = cA + (size_t)(t + 1) * kstep;
            const char* a2 = last ? nA : cA + (size_t)(t + 2) * kstep; const char* b2 = last ? nB : cB + (size_t)(t + 2) * kstep;
            const char* a3 = a2 + kstep; const char* b3 = b2 + kstep;
            if (last && has_next) S.a_ready(nxt);
            PG8_LDB(B0, 0, 0); PG8_SCHED; PG8_LDA(At, 0, 0); PG8_STAGE(PG8_SA(1, 1), a1 + hstep, voffA);
            PG8_WAIT_L(8); PG8_BAR; PG8_WAIT_L(0); PG8_MMA(0, 0, At, B0); PG8_BAR; PG8_SCHED;
            PG8_LDB(B1, 0, 1); PG8_STAGE(PG8_SB(0, 0), b2, voffB);
            PG8_BAR; PG8_WAIT_L(0); PG8_MMA(0, 1, At, B1); PG8_BAR;
            PG8_LDA(At, 0, 1); PG8_STAGE(PG8_SA(0, 0), a2, voffA);
            PG8_BAR; PG8_WAIT_L(0); PG8_MMA(1, 0, At, B0); PG8_BAR; PG8_SCHED;
            PG8_STAGE(PG8_SB(0, 1), b2 + hstep, voffB);
            PG8_WAIT_V(6); PG8_BAR; PG8_MMA(1, 1, At, B1); PG8_BAR;
            PG8_LDB(B0, 1, 0); PG8_SCHED; PG8_LDA(At, 1, 0); PG8_STAGE(PG8_SA(0, 1), a2 + hstep, voffA);
            PG8_WAIT_L(8); PG8_BAR; PG8_WAIT_L(0); PG8_MMA(0, 0, At, B0); PG8_BAR; PG8_SCHED;
            PG8_LDB(B1, 1, 1); PG8_STAGE(PG8_SB(1, 0), b3, voffB);
            PG8_BAR; PG8_WAIT_L(0); PG8_MMA(0, 1, At, B1); PG8_BAR;
            PG8_LDA(At, 1, 1); PG8_STAGE(PG8_SA(1, 0), a3, voffA);
            PG8_BAR; PG8_WAIT_L(0); PG8_MMA(1, 0, At, B0); PG8_BAR; PG8_SCHED;
            PG8_STAGE(PG8_SB(1, 1), b3 + hstep, voffB);
            PG8_WAIT_V(6); PG8_BAR; PG8_MMA(1, 1, At, B1); PG8_BAR;
        }
        PG8_STAMP();
        if constexpr (!Epi::AFTER_DRAIN) { E(acc, cur, wr, wc, fr, fq); S.done(cur); }
        PG8_STAMP();
        if (!has_next) break;
#pragma unroll
        for (int a = 0; a < 2; ++a)
#pragma unroll
            for (int b = 0; b < 2; ++b)
#pragma unroll
                for (int m = 0; m < 4; ++m)
#pragma unroll
                    for (int n = 0; n < 2; ++n) acc[a][b][m][n] = (f32x4){0.f, 0.f, 0.f, 0.f};
        cur = nxt; cA = nA; cB = nB; ++ui;
    }
    PG8_WAIT_V(0);
    if (wr == 0) PG8_BAR;
    PG8_BAR;
    if constexpr (Epi::AFTER_DRAIN) { E.fused(acc, cur, wr, wc, fr, fq, lds, wid, lane); S.done(cur); }
    PG8_STAMP();
    if (STAMP && wid == 0) { stamps[lane] = lane < nts ? (((unsigned long long)(unsigned)ts_hi << 32) | (unsigned)ts_lo) : 0ull;
        if (lane == 62) stamps[62] = rt_entry; if (lane == 63) stamps[63] = (unsigned long long)wall_clock64(); }
#undef PG8_STAMP
#undef PG8_SA
#undef PG8_SB
#undef PG8_STAGE
#undef PG8_LDA
#undef PG8_LDB
#undef PG8_MMA
#undef PG8_WAIT_V
#undef PG8_WAIT_L
#undef PG8_BAR
#undef PG8_SCHED
}
}
using pg8::bf16_t; using pg8::bf16x8; using pg8::f32x4; using pg8::u32x4; using pg8::cvt_pk_bf16;
typedef short bf16x4 __attribute__((ext_vector_type(4)));
typedef unsigned u32x2 __attribute__((ext_vector_type(2)));

constexpr int NTOK = 16384, SEQ = 8192, DM = 2048, NBATCH = 2;
constexpr int NSA_NP = 7424, NSA_IN = 7216, HG_NP = 8192;
constexpr int Q0 = 0, KC0 = 2048, VC0 = 2560, KS0 = 3072, VS0 = 3584, KW0 = 4096, VW0 = 4608, Z0 = 5120, GL0 = 7168;
constexpr int NTHR = 512;
constexpr int LDS_BYTES = 147456;
constexpr float RMS_EPS = 1e-6f;
constexpr size_t WS_WIN = 0;
constexpr size_t WS_WOUT = WS_WIN + (size_t)8192 * 2048 * 2;
constexpr size_t WS_W1T = WS_WOUT + (size_t)2048 * 2048 * 2;
constexpr size_t WS_W2T = WS_W1T + (size_t)4 * 128 * 4096 * 2;
constexpr size_t WS_CBIAS = WS_W2T + (size_t)4 * 128 * 128 * 2;
constexpr size_t WS_LB = WS_CBIAS + 4096;
constexpr size_t WS_ROPE = WS_LB + (size_t)2 * 2048 * 4;
constexpr size_t WS_SSQ = WS_ROPE + (size_t)NTOK * 32 * 4;
constexpr size_t WS_XB = WS_SSQ + (size_t)5 * NTOK * 4;
constexpr size_t WS_PROJ = WS_XB + (size_t)NTOK * 2048 * 2;
constexpr size_t WS_OBUF = WS_PROJ + (size_t)NTOK * 8192 * 2;
constexpr size_t WS_KCMP = WS_OBUF + (size_t)NTOK * 2048 * 2;
constexpr size_t WS_VCMPT = WS_KCMP + (size_t)8 * 512 * 128 * 2;
constexpr size_t WS_VST = WS_VCMPT + (size_t)8 * 512 * 128 * 2;
constexpr size_t WS_VWT = WS_VST + (size_t)8 * 128 * 8192 * 2;
constexpr size_t WS_HSEG = WS_VST;
constexpr size_t WS_WIN2 = WS_VWT + (size_t)8 * 128 * 8192 * 2;
constexpr int HSEG_STRIDE = 128 * 128 + 128;
constexpr size_t WS_END = WS_WIN2 + (size_t)8192 * 2048 * 2;
static_assert((size_t)256 * HSEG_STRIDE * 4 <= (size_t)2 * 8 * 128 * 8192 * 2, "hseg alias");
constexpr size_t WS_BAR = WS_END;
constexpr size_t WS_END2 = WS_BAR + 16384;

struct Params {
    const float* x; const int* pos; const float* norm_w; const float* fnorm_w;
    const float* nsa_w_in; const float* ck_pos; const float* ck_w1; const float* ck_w2;
    const float* cv_pos; const float* cv_w1; const float* cv_w2; const float* nsa_w_out;
    const float* hg_w_in; const float* hg_lb; const float* hg_gn; const float* hg_w_out;
    float* out; unsigned char* ws; int ph_lo, ph_hi, coop, pad;
};

__device__ __forceinline__ bf16_t f2bf(float f) { unsigned u = __float_as_uint(f); u += 0x7FFFu + ((u >> 16) & 1u); return (bf16_t)(u >> 16); }
__device__ __forceinline__ float bf2f(bf16_t b) { return __uint_as_float(((unsigned)b) << 16); }
__device__ __forceinline__ float bflo(unsigned w) { return __uint_as_float(w << 16); }
__device__ __forceinline__ float bfhi(unsigned w) { return __uint_as_float(w & 0xffff0000u); }
__device__ __forceinline__ f32x4 mfma16(bf16x8 a, bf16x8 b, f32x4 c) { return __builtin_amdgcn_mfma_f32_16x16x32_bf16(a, b, c, 0, 0, 0); }
__device__ __forceinline__ float sigmoidf_(float v) { return __builtin_amdgcn_rcpf(1.0f + __expf(-v)); }
__device__ __forceinline__ float siluf_(float v) { return v * __builtin_amdgcn_rcpf(1.0f + __expf(-v)); }
__device__ __forceinline__ bf16x8 pack8f(const float* v) { u32x4 w = {cvt_pk_bf16(v[0], v[1]), cvt_pk_bf16(v[2], v[3]), cvt_pk_bf16(v[4], v[5]), cvt_pk_bf16(v[6], v[7])}; return *reinterpret_cast<bf16x8*>(&w); }
__device__ __forceinline__ bf16x8 pack44(f32x4 a, f32x4 b) { u32x4 w = {cvt_pk_bf16(a[0], a[1]), cvt_pk_bf16(a[2], a[3]), cvt_pk_bf16(b[0], b[1]), cvt_pk_bf16(b[2], b[3])}; return *reinterpret_cast<bf16x8*>(&w); }

__device__ __forceinline__ float row16_sum(float v) {
    v += __int_as_float(__builtin_amdgcn_update_dpp(0, __float_as_int(v), 0xB1, 0xF, 0xF, true));
    v += __int_as_float(__builtin_amdgcn_update_dpp(0, __float_as_int(v), 0x4E, 0xF, 0xF, true));
    v += __int_as_float(__builtin_amdgcn_update_dpp(0, __float_as_int(v), 0x124, 0xF, 0xF, true));
    v += __int_as_float(__builtin_amdgcn_update_dpp(0, __float_as_int(v), 0x128, 0xF, 0xF, true));
    return v;
}
__device__ __forceinline__ float rows4_sum(float v) {
    { auto r = __builtin_amdgcn_permlane16_swap(__float_as_uint(v), __float_as_uint(v), false, false); v = __uint_as_float(r[0]) + __uint_as_float(r[1]); }
    { auto r = __builtin_amdgcn_permlane32_swap(__float_as_uint(v), __float_as_uint(v), false, false); v = __uint_as_float(r[0]) + __uint_as_float(r[1]); }
    return v;
}
__device__ __forceinline__ int nsa_col(int n) { return n < 5120 ? n : (n < 7168 ? n + 48 : (n < 7216 ? n - 2048 : -1)); }
template <int MODE>
__device__ __forceinline__ void tconv(const float* __restrict__ src, int ldsrc, int nsrc, bf16_t* __restrict__ dst, int Kdim, int Ndst, const float* __restrict__ rowscale, float* tile, int blk, int nblk) {
    const int tid = get_tid(), nkt = Kdim / 64, nnt = Ndst / 64, ntile = nkt * nnt;
    constexpr int TU = 2;
    for (int it0 = blk; it0 < ntile; it0 += TU * nblk) {
        f32x4 v[TU][2];
#pragma unroll
        for (int u = 0; u < TU; ++u) {
            const int it = it0 + u * nblk;
            if (it < ntile) {
                const int k0 = (it % nkt) * 64, n0 = (it / nkt) * 64;
#pragma unroll
                for (int i = 0; i < 2; ++i) {
                    const int kr = (tid >> 4) + 32 * i, c4 = (tid & 15) * 4, n = n0 + c4;
                    const int sc = MODE == 1 ? nsa_col(n) : (n < nsrc ? n : -1);
                    v[u][i] = (f32x4){0.f, 0.f, 0.f, 0.f};
                    if (sc >= 0) v[u][i] = *(const f32x4*)(src + (size_t)(k0 + kr) * ldsrc + sc);
                    if (rowscale) { const float s = rowscale[k0 + kr]; v[u][i] = v[u][i] * s; }
                }
            }
        }
        __syncthreads();
#pragma unroll
        for (int u = 0; u < TU; ++u)
#pragma unroll
            for (int i = 0; i < 2; ++i) {
                const int kr = (tid >> 4) + 32 * i, c4 = (tid & 15) * 4; float* tl = tile + u * (64 * 65);
                tl[kr * 65 + c4 + 0] = v[u][i][0]; tl[kr * 65 + c4 + 1] = v[u][i][1]; tl[kr * 65 + c4 + 2] = v[u][i][2]; tl[kr * 65 + c4 + 3] = v[u][i][3];
            }
        __syncthreads();
#pragma unroll
        for (int u = 0; u < TU; ++u) {
            const int it = it0 + u * nblk;
            if (it < ntile) {
                const int k0 = (it % nkt) * 64, n0 = (it / nkt) * 64; const float* tl = tile + u * (64 * 65);
                const int nr = tid >> 3, k8 = (tid & 7) * 8; float o[8];
#pragma unroll
                for (int j = 0; j < 8; ++j) o[j] = tl[(k8 + j) * 65 + nr];
                *(bf16x8*)(dst + (size_t)(n0 + nr) * Kdim + k0 + k8) = pack8f(o);
            }
        }
    }
    __syncthreads();
}

struct EpiNsaIn {
    static constexpr bool PERM = true, AFTER_DRAIN = false;
    bf16_t* proj; const float* ssq; const float* rope;
    __device__ __forceinline__ void operator()(const f32x4 (&acc)[2][2][4][2], const pg8::Unit& u, int wr, int wc, int fr, int fq) const {
        const int pn = u.pn;
        const bool is_rope = (pn < 10) || pn == 12 || pn == 13 || pn == 16 || pn == 17;
        const int mode = (pn >= 20 && pn < 28) ? 1 : (pn == 28 ? 2 : 0);
        const bool do_rope = is_rope && (wc == 0);
#pragma unroll
        for (int ai = 0; ai < 2; ++ai)
#pragma unroll
            for (int m = 0; m < 4; ++m) {
                const int row = u.pm * 256 + ai * 128 + wr * 64 + m * 16 + fr;
                const float rs = rsqrtf(ssq[row] * (1.0f / 2048.0f) + RMS_EPS);
                f32x4 c0 = {1.f, 1.f, 1.f, 1.f}, c1 = c0, s0 = {0.f, 0.f, 0.f, 0.f}, s1 = s0;
                if (do_rope) { const float* cp = rope + (size_t)row * 32 + 8 * (fq & 1); c0 = *(const f32x4*)cp; c1 = *(const f32x4*)(cp + 4); s0 = *(const f32x4*)(cp + 16); s1 = *(const f32x4*)(cp + 20);
                    if (fq < 2) { s0 = -s0; s1 = -s1; } }
#pragma unroll
                for (int bj = 0; bj < 2; ++bj) {
                    float v[8];
#pragma unroll
                    for (int j = 0; j < 4; ++j) { v[j] = acc[ai][bj][m][0][j] * rs; v[4 + j] = acc[ai][bj][m][1][j] * rs; }
                    if (do_rope) {
#pragma unroll
                        for (int e = 0; e < 8; ++e) { const auto sw = __builtin_amdgcn_permlane32_swap(__float_as_uint(v[e]), __float_as_uint(v[e]), false, false); const float pr = __uint_as_float(fq < 2 ? sw[1] : sw[0]);     const float c = e < 4 ? c0[e & 3] : c1[e & 3], s = e < 4 ? s0[e & 3] : s1[e & 3]; v[e] = v[e] * c + pr * s; }
                    }
                    if (mode == 1) {
#pragma unroll
                        for (int e = 0; e < 8; ++e) v[e] = siluf_(v[e]);
                    } else if (mode == 2) {
#pragma unroll
                        for (int e = 0; e < 8; ++e) v[e] = sigmoidf_(v[e]);
                    }
                    *(bf16x8*)(proj + (size_t)row * NSA_NP + pn * 256 + bj * 128 + wc * 32 + 8 * fq) = pack8f(v);
                }
            }
    }
};
struct EpiHgIn {
    static constexpr bool PERM = true, AFTER_DRAIN = false;
    bf16_t* proj; const float* ssq; const float* lb;
    __device__ __forceinline__ void operator()(const f32x4 (&acc)[2][2][4][2], const pg8::Unit& u, int wr, int wc, int fr, int fq) const {
        const int pn = u.pn; const int mode = pn < 8 ? 1 : (pn < 16 ? 3 : (pn < 24 ? 0 : 1));
#pragma unroll
        for (int ai = 0; ai < 2; ++ai)
#pragma unroll
            for (int m = 0; m < 4; ++m) {
                const int row = u.pm * 256 + ai * 128 + wr * 64 + m * 16 + fr;
                const float rs = rsqrtf(ssq[row] * (1.0f / 2048.0f) + RMS_EPS);
#pragma unroll
                for (int bj = 0; bj < 2; ++bj) {
                    const int col = pn * 256 + bj * 128 + wc * 32 + 8 * fq;
                    float v[8];
#pragma unroll
                    for (int j = 0; j < 4; ++j) { v[j] = acc[ai][bj][m][0][j] * rs; v[4 + j] = acc[ai][bj][m][1][j] * rs; }
                    if (mode == 1) {
#pragma unroll
                        for (int e = 0; e < 8; ++e) v[e] = siluf_(v[e]);
                    } else if (mode == 3) {
                        const f32x4 l0 = *(const f32x4*)(lb + col - 2048), l1 = *(const f32x4*)(lb + col - 2048 + 4);
#pragma unroll
                        for (int e = 0; e < 8; ++e) { const float l = e < 4 ? l0[e & 3] : l1[e & 3]; const float f = l + (1.0f - l) * sigmoidf_(v[e]); v[e] = __logf(f); }
                    }
                    *(bf16x8*)(proj + (size_t)row * HG_NP + col) = pack8f(v);
                }
            }
    }
};
struct EpiPlain {
    static constexpr bool PERM = true, AFTER_DRAIN = false;
    bf16_t* proj; int ldc;
    __device__ __forceinline__ void operator()(const f32x4 (&acc)[2][2][4][2], const pg8::Unit& u, int wr, int wc, int fr, int fq) const {
#pragma unroll
        for (int ai = 0; ai < 2; ++ai)
#pragma unroll
            for (int m = 0; m < 4; ++m) { const int row = u.pm * 256 + ai * 128 + wr * 64 + m * 16 + fr;
#pragma unroll
                for (int bj = 0; bj < 2; ++bj) *(bf16x8*)(proj + (size_t)row * ldc + u.pn * 256 + bj * 128 + wc * 32 + 8 * fq) = pack44(acc[ai][bj][m][0], acc[ai][bj][m][1]); }
    }
};
struct EpiOut {
    static constexpr bool PERM = false, AFTER_DRAIN = false;
    const float* xin; float* xout; bf16_t* xb; float* ssq;
    __device__ __forceinline__ void operator()(const f32x4 (&acc)[2][2][4][2], const pg8::Unit& u, int wr, int wc, int fr, int fq) const {
#pragma unroll
        for (int ai = 0; ai < 2; ++ai)
#pragma unroll
            for (int m = 0; m < 4; ++m) {
                const int row = u.pm * 256 + ai * 128 + wr * 64 + m * 16 + fr; float ss = 0.f;
#pragma unroll
                for (int bj = 0; bj < 2; ++bj)
#pragma unroll
                    for (int n = 0; n < 2; ++n) {
                        const size_t off = (size_t)row * DM + u.pn * 256 + bj * 128 + wc * 32 + n * 16 + 4 * fq;
                        const f32x4 xo = *(const f32x4*)(xin + off); const f32x4 xn = xo + acc[ai][bj][m][n];
                        *(f32x4*)(xout + off) = xn;
                        u32x2 w; w.x = cvt_pk_bf16(xn[0], xn[1]); w.y = cvt_pk_bf16(xn[2], xn[3]); *(u32x2*)(xb + off) = w;
                        ss += xn[0] * xn[0] + xn[1] * xn[1] + xn[2] * xn[2] + xn[3] * xn[3];
                    }
                ss = rows4_sum(ss);
                if (fq == 0) atomicAdd(ssq + row, ss);
            }
    }
};
__device__ __forceinline__ void phase_prep(const Params& p, unsigned char* smem) {
    const int tid = get_tid(), lane = tid & 63, wave = tid >> 6, blk = blockIdx.x, nblk = gridDim.x;
    unsigned char* ws = p.ws;
    float* ssq = (float*)(ws + WS_SSQ); bf16_t* xb = (bf16_t*)(ws + WS_XB);
    for (int row = blk * 8 + wave; row < NTOK; row += nblk * 8) {
        const float* xr = p.x + (size_t)row * DM; float ss = 0.f;
#pragma unroll
        for (int i = 0; i < 4; ++i) {
            const int c = (i * 64 + lane) * 8; const f32x4 a = *(const f32x4*)(xr + c), b = *(const f32x4*)(xr + c + 4);
            ss += a[0] * a[0] + a[1] * a[1] + a[2] * a[2] + a[3] * a[3] + b[0] * b[0] + b[1] * b[1] + b[2] * b[2] + b[3] * b[3];
            *(bf16x8*)(xb + (size_t)row * DM + c) = pack44(a, b);
        }
#pragma unroll
        for (int o = 32; o >= 1; o >>= 1) ss += __shfl_xor(ss, o);
        if (lane == 0) ssq[row] = ss;
    }
    const int gtid = blk * NTHR + tid, gn = nblk * NTHR;
    for (int i = gtid; i < 4 * NTOK; i += gn) ssq[NTOK + i] = 0.f;
    float* rope = (float*)(ws + WS_ROPE);
    for (int i = gtid; i < NTOK * 16; i += gn) {
        const int t = i >> 4, f = i & 15;
        const float inv = powf(500000.0f, -(float)f / 16.0f);
        const float ang = (float)p.pos[t] * inv;
        double fr = (double)ang * 0.15915494309189533577; fr -= rint(fr);
        rope[t * 32 + f] = __builtin_amdgcn_cosf((float)fr); rope[t * 32 + 16 + f] = __builtin_amdgcn_sinf((float)fr);
    }
    if (gtid < 2) ((unsigned*)(ws + WS_CBIAS + 2048 + 64))[gtid] = 0u;
    float* lb = (float*)(ws + WS_LB);
    for (int i = gtid; i < 2048; i += gn) { const float a0 = p.hg_lb[i], a1 = p.hg_lb[2048 + i]; lb[i] = 0.f; lb[2048 + i] = 1.0f / (1.0f + __expf(a0 - a1)); }
    float* cb = (float*)(ws + WS_CBIAS);
    for (int it = blk * 8 + wave; it < 512; it += nblk * 8) {
        const int which = it >> 7, h = it & 127, layer = which >> 1;
        const float* pos = ((which & 1) ? p.cv_pos : p.ck_pos) + (size_t)layer * 4096;
        const float* w1 = ((which & 1) ? p.cv_w1 : p.ck_w1) + (size_t)layer * 4096 * 128;
        float s = 0.f;
        for (int k = lane; k < 4096; k += 64) s += pos[k] * w1[(size_t)k * 128 + h];
#pragma unroll
        for (int o = 32; o >= 1; o >>= 1) s += __shfl_xor(s, o);
        if (lane == 0) cb[which * 128 + h] = s;
    }
    float* tile = (float*)smem;
    for (int which = 0; which < 4; ++which) {
        const int layer = which >> 1;
        const float* w1 = ((which & 1) ? p.cv_w1 : p.ck_w1) + (size_t)layer * 4096 * 128;
        const float* w2 = ((which & 1) ? p.cv_w2 : p.ck_w2) + (size_t)layer * 128 * 128;
        tconv<0>(w1, 128, 128, (bf16_t*)(ws + WS_W1T) + (size_t)which * 128 * 4096, 4096, 128, nullptr, tile, blk, nblk);
        tconv<0>(w2, 128, 128, (bf16_t*)(ws + WS_W2T) + (size_t)which * 128 * 128, 128, 128, nullptr, tile, blk, nblk);
    }
    tconv<1>(p.nsa_w_in, NSA_IN, NSA_IN, (bf16_t*)(ws + WS_WIN), 2048, NSA_NP, p.norm_w, tile, blk, nblk);
}

__device__ __forceinline__ void compress_item(const Params& p, int nl, int item, unsigned char* smem) {
    const int tid = get_tid(), lane = tid & 63, w = tid >> 6, l15 = lane & 15, quad = lane >> 4;
    const int kv = item >> 7, bg = (item >> 4) & 7, nt = item & 15, b = bg >> 2, g = bg & 3, n0 = nt * 32;
    const int which = nl * 2 + kv;
    unsigned char* ws = p.ws;
    const bf16_t* proj = (const bf16_t*)(ws + WS_PROJ);
    const bf16_t* w1t = (const bf16_t*)(ws + WS_W1T) + (size_t)which * 128 * 4096;
    const bf16_t* w2t = (const bf16_t*)(ws + WS_W2T) + (size_t)which * 128 * 128;
    const float* cb = (const float*)(ws + WS_CBIAS) + which * 128;
    const int col0 = (kv ? VC0 : KC0) + g * 128;
    f32x4 acc[2] = {{0.f, 0.f, 0.f, 0.f}, {0.f, 0.f, 0.f, 0.f}};
    const bf16_t* brow = w1t + (size_t)(16 * w + l15) * 4096 + quad * 8;
    constexpr int CAP = 264, CABUF = 32 * 264 * 2;
    unsigned char* abuf = smem + 16384;
    bf16x8 areg[2];
#define CMP_LOAD(gg) do { _Pragma("unroll") for (int i_ = 0; i_ < 2; ++i_) { const int id_ = tid + 512 * i_, n_ = id_ >> 5, c8_ = (id_ & 31) * 8; \
        int tok_ = 16 * (n0 + n_) + 2 * (gg) + (c8_ >> 7); tok_ = tok_ > SEQ - 1 ? SEQ - 1 : tok_; \
        areg[i_] = *(const bf16x8*)(proj + (size_t)(b * SEQ + tok_) * NSA_NP + col0 + (c8_ & 127)); } } while (0)
#define CMP_WRITE(bufp) do { _Pragma("unroll") for (int i_ = 0; i_ < 2; ++i_) { const int id_ = tid + 512 * i_, n_ = id_ >> 5, c8_ = (id_ & 31) * 8; \
        *(bf16x8*)((bf16_t*)(bufp) + n_ * CAP + c8_) = areg[i_]; } } while (0)
    CMP_LOAD(0);
    __syncthreads();
    CMP_WRITE(abuf);
    __syncthreads();
    CMP_LOAD(1);
    for (int gg = 0; gg < 16; ++gg) {
        const bf16_t* sA = (const bf16_t*)(abuf + (gg & 1) * CABUF);
        bf16x8 bf[8];
#pragma unroll
        for (int kk = 0; kk < 8; ++kk) bf[kk] = *(const bf16x8*)(brow + (gg * 8 + kk) * 32);
#pragma unroll
        for (int kk = 0; kk < 8; ++kk)
#pragma unroll
            for (int rt = 0; rt < 2; ++rt) {
                const bf16x8 af = *(const bf16x8*)(sA + (rt * 16 + l15) * CAP + kk * 32 + quad * 8);
                acc[rt] = mfma16(af, bf[kk], acc[rt]);
            }
        if (gg + 1 < 16) CMP_WRITE(abuf + ((gg & 1) ^ 1) * CABUF);
        __syncthreads();
        if (gg + 2 < 16) CMP_LOAD(gg + 2);
    }
#undef CMP_LOAD
#undef CMP_WRITE
    bf16_t* sHid = (bf16_t*)smem;
    __syncthreads();
    { const float bias = cb[16 * w + l15];
#pragma unroll
      for (int rt = 0; rt < 2; ++rt)
#pragma unroll
          for (int j = 0; j < 4; ++j) sHid[(rt * 16 + quad * 4 + j) * 136 + 16 * w + l15] = f2bf(siluf_(acc[rt][j] + bias)); }
    __syncthreads();
    f32x4 oc[2] = {{0.f, 0.f, 0.f, 0.f}, {0.f, 0.f, 0.f, 0.f}};
#pragma unroll
    for (int kk = 0; kk < 4; ++kk) {
        const bf16x8 bf = *(const bf16x8*)(w2t + (size_t)(16 * w + l15) * 128 + kk * 32 + quad * 8);
#pragma unroll
        for (int rt = 0; rt < 2; ++rt) { const bf16x8 af = *(const bf16x8*)(sHid + (rt * 16 + l15) * 136 + kk * 32 + quad * 8); oc[rt] = mfma16(af, bf, oc[rt]); }
    }
    if (kv == 0) {
        bf16_t* kc = (bf16_t*)(ws + WS_KCMP) + (size_t)bg * 512 * 128;
#pragma unroll
        for (int rt = 0; rt < 2; ++rt)
#pragma unroll
            for (int j = 0; j < 4; ++j) { const int n = n0 + rt * 16 + quad * 4 + j; kc[(size_t)n * 128 + 16 * w + l15] = n < 511 ? f2bf(oc[rt][j]) : (bf16_t)0; }
    } else {
        bf16_t* vct = (bf16_t*)(ws + WS_VCMPT) + (size_t)bg * 128 * 512;
#pragma unroll
        for (int rt = 0; rt < 2; ++rt) {
            const int n = n0 + rt * 16 + quad * 4; f32x4 v = oc[rt]; if (n + 3 >= 511) v[3] = 0.f;
            u32x2 wv; wv.x = cvt_pk_bf16(v[0], v[1]); wv.y = cvt_pk_bf16(v[2], v[3]);
            *(u32x2*)(vct + (size_t)(16 * w + l15) * 512 + n) = wv;
        }
    }
    __syncthreads();
}
__device__ __forceinline__ void vtrans_item(const Params& p, int item, unsigned char* smem) {
    const int tid = get_tid(); const int which = item >> 10, bg = (item >> 7) & 7, tt = item & 127, b = bg >> 2, g = bg & 3, s0 = tt * 64;
    const bf16_t* proj = (const bf16_t*)(p.ws + WS_PROJ);
    bf16_t* dst = (bf16_t*)(p.ws + (which ? WS_VWT : WS_VST)) + (size_t)bg * 128 * SEQ;
    const int col0 = (which ? VW0 : VS0) + g * 128;
    bf16_t* t = (bf16_t*)smem;
    __syncthreads();
#pragma unroll
    for (int i = 0; i < 2; ++i) { const int c = tid + 512 * i, r = c >> 4, c8 = (c & 15) * 8;
        *(bf16x8*)(t + r * 136 + c8) = *(const bf16x8*)(proj + (size_t)(b * SEQ + s0 + r) * NSA_NP + col0 + c8); }
    __syncthreads();
    { const int d = tid >> 2, k16 = (tid & 3) * 16; bf16x8 o0, o1;
#pragma unroll
      for (int j = 0; j < 8; ++j) { o0[j] = (short)t[(k16 + j) * 136 + d]; o1[j] = (short)t[(k16 + 8 + j) * 136 + d]; }
      *(bf16x8*)(dst + (size_t)d * SEQ + s0 + k16) = o0; *(bf16x8*)(dst + (size_t)d * SEQ + s0 + k16 + 8) = o1; }
}
#ifndef ATT_SKIP
#define ATT_SKIP 0
#endif
#ifndef ATT_REPEAT
#define ATT_REPEAT 0
#endif
#ifndef DEBUG_TIMER
#define DEBUG_TIMER 0
#endif
#if DEBUG_TIMER
#define TMR_BEGIN(k) unsigned long long tmr_##k = wall_clock64();
#define TMR_END(k) if (blockIdx.x == DEBUG_TIMER_BLOCK && tid == 0 && ((DEBUG_TIMER >> k) & 1)) { unsigned long long* acc_t = (unsigned long long*)(p.ws + WS_CBIAS + 2048 + 16); *acc_t += wall_clock64() - tmr_##k; }
#else
#define TMR_BEGIN(k)
#define TMR_END(k)
#endif
constexpr int SKP = 136, SVP = 72;
constexpr int A_BUFSZ = 35840, A_SVOFF = 17408, A_IMP = 71680, A_ACC = 71680, A_ACCW = 8704, A_SEL = 141312;
constexpr float ATT_C2 = 0.08838834764831845f * 1.4426950408889634f;

__device__ __forceinline__ float xrow_max(float v) {
    { auto r = __builtin_amdgcn_permlane16_swap(__float_as_uint(v), __float_as_uint(v), false, false); v = fmaxf(__uint_as_float(r[0]), __uint_as_float(r[1])); }
    { auto r = __builtin_amdgcn_permlane32_swap(__float_as_uint(v), __float_as_uint(v), false, false); v = fmaxf(__uint_as_float(r[0]), __uint_as_float(r[1])); }
    return v;
}
__device__ __forceinline__ float xrow_sum(float v) {
    { auto r = __builtin_amdgcn_permlane16_swap(__float_as_uint(v), __float_as_uint(v), false, false); v = __uint_as_float(r[0]) + __uint_as_float(r[1]); }
    { auto r = __builtin_amdgcn_permlane32_swap(__float_as_uint(v), __float_as_uint(v), false, false); v = __uint_as_float(r[0]) + __uint_as_float(r[1]); }
    return v;
}
__device__ __forceinline__ float quad_sum(float v) {
    v += __int_as_float(__builtin_amdgcn_update_dpp(0, __float_as_int(v), 0xB1, 0xF, 0xF, true));
    v += __int_as_float(__builtin_amdgcn_update_dpp(0, __float_as_int(v), 0x4E, 0xF, 0xF, true));
    return v;
}
template <int MODE>
__device__ __forceinline__ void attn_softmax(f32x4 (&st)[4], int tpos, int key0, bool need_mask, bool rowsel, float& mrow, float& lrow, f32x4 (&oq)[8], bf16x8 (&pf)[2], float il, float* impRow, int lane) {
    const int quad = lane >> 4;
    float x[4][4]; float mx = -1e30f;
#pragma unroll
    for (int kt = 0; kt < 4; ++kt)
#pragma unroll
        for (int j = 0; j < 4; ++j) {
            float v = st[kt][j];
            if (need_mask) {
                const int key = key0 + kt * 16 + quad * 4 + j; bool vis;
                if (MODE <= 1) vis = (16 * key + 31 <= tpos);
                else if (MODE == 2) vis = (key <= tpos) && (key > tpos - 512);
                else vis = (key <= tpos);
                v = vis ? v : -1e30f;
            }
            x[kt][j] = v; mx = fmaxf(mx, v);
        }
    if (MODE == 1) {
        const float me = mrow > -1e29f ? mrow : 1e30f;
#pragma unroll
        for (int kt = 0; kt < 4; ++kt) {
#pragma unroll
            for (int j = 0; j < 4; ++j) x[kt][j] = __builtin_amdgcn_exp2f(fmaxf(x[kt][j] - me, -126.f)) * il;
        }
        float A[4], E[4];
#pragma unroll
        for (int kt = 0; kt < 4; ++kt) { A[kt] = (x[kt][0] + x[kt][1]) + (x[kt][2] + x[kt][3]); E[kt] = x[kt][3];
            A[kt] = quad_sum(A[kt]); E[kt] = quad_sum(E[kt]); }
        if ((lane & 3) == 0) {
#pragma unroll
            for (int kt = 0; kt < 4; ++kt) impRow[key0 / 4 + kt * 4 + quad] += A[kt];
            asm volatile("s_waitcnt lgkmcnt(0)" ::: "memory");
#pragma unroll
            for (int kt = 0; kt < 4; ++kt) impRow[key0 / 4 + kt * 4 + quad + 1] += E[kt];
        }
    } else {
        if (MODE == 3) mx = rowsel ? mx : -1e30f;
        mx = xrow_max(mx);
        const float mn = fmaxf(mrow, mx);
        const float alpha = __builtin_amdgcn_exp2f(fmaxf(mrow - mn, -126.f)); mrow = mn;
        const float me = (mn > -1e29f && (MODE != 3 || rowsel)) ? mn : 1e30f;
        float rs = 0.f;
#pragma unroll
        for (int kt = 0; kt < 4; ++kt)
#pragma unroll
            for (int j = 0; j < 4; ++j) { x[kt][j] = __builtin_amdgcn_exp2f(fmaxf(x[kt][j] - me, -126.f)); rs += x[kt][j]; }
        rs = xrow_sum(rs);
        lrow = lrow * alpha + rs;
        if (MODE != 0) { if (__any((int)(alpha != 1.0f))) {
#pragma unroll
            for (int dt = 0; dt < 8; ++dt) oq[dt] = oq[dt] * alpha; } }
    }
    if (MODE != 0) {
#pragma unroll
        for (int ks = 0; ks < 2; ++ks) {
            u32x4 wv = {cvt_pk_bf16(x[2 * ks][0], x[2 * ks][1]), cvt_pk_bf16(x[2 * ks][2], x[2 * ks][3]), cvt_pk_bf16(x[2 * ks + 1][0], x[2 * ks + 1][1]), cvt_pk_bf16(x[2 * ks + 1][2], x[2 * ks + 1][3])};
            pf[ks] = *reinterpret_cast<bf16x8*>(&wv);
        }
    }
}

template <int MODE>
__device__ __forceinline__ void attn_branch(const bf16_t* __restrict__ kbase, int kpitch, const bf16_t* __restrict__ vtbase, int vtile, int vrow, int t_lo, int t_hi,
                                            const bf16x8 (&qf)[2][4], const int (&tq)[2], float (&mrow)[2], float (&lrow)[2], f32x4 (&o)[2][8],
                                            const unsigned long long (&selm)[2][2], unsigned char* smem, int wtok0, int qi) {
    const int tid = get_tid(), lane = tid & 63, w = tid >> 6, l15 = lane & 15, quad = lane >> 4;
    float* sImp = (float*)(smem + A_IMP); const unsigned* sSelW = (const unsigned*)(smem + A_SEL) + w * 8 * 4;
    bf16x8 kregA[2], vregA[2], kregB[2], vregB[2];
    const int krow = tid >> 4, kc8 = (tid & 15) * 8, vd = tid >> 3, vk8 = (tid & 7) * 8;
#define ATT_LOAD(kreg, vreg, tt) do { _Pragma("unroll") for (int i_ = 0; i_ < 2; ++i_) { kreg[i_] = *(const bf16x8*)(kbase + (size_t)((tt) * 64 + krow + 32 * i_) * kpitch + kc8); \
        if (MODE != 0) vreg[i_] = *(const bf16x8*)(vtbase + (size_t)(tt) * vtile + (size_t)(vd + 64 * i_) * vrow + vk8); } } while (0)
#define ATT_WRITE(kreg, vreg, bufp) do { _Pragma("unroll") for (int i_ = 0; i_ < 2; ++i_) { *(bf16x8*)((bf16_t*)(bufp) + (krow + 32 * i_) * SKP + kc8) = kreg[i_]; \
        if (MODE != 0) { bf16_t* vrow_ = (bf16_t*)((bufp) + A_SVOFF) + (vd + 64 * i_) * SVP + (vk8 & 32); const int m_ = (vk8 >> 3) & 3; \
            const bf16x4 p0_ = {vreg[i_][0], vreg[i_][1], vreg[i_][2], vreg[i_][3]}, p1_ = {vreg[i_][4], vreg[i_][5], vreg[i_][6], vreg[i_][7]}; \
            *(bf16x4*)(vrow_ + 8 * ((2 * m_) & 3) + 4 * (m_ >> 1)) = p0_; *(bf16x4*)(vrow_ + 8 * ((2 * m_ + 1) & 3) + 4 * (m_ >> 1)) = p1_; } } } while (0)
    constexpr bool DEEP = false;
    if (t_lo < t_hi) ATT_LOAD(kregA, vregA, t_lo);
    if (DEEP) { if (t_lo + 1 < t_hi) ATT_LOAD(kregB, vregB, t_lo + 1); }
    __syncthreads();
    if (t_lo < t_hi) ATT_WRITE(kregA, vregA, smem);
    __syncthreads();
    if (DEEP) { if (t_lo + 2 < t_hi) ATT_LOAD(kregA, vregA, t_lo + 2); }
    else { if (t_lo + 1 < t_hi) ATT_LOAD(kregA, vregA, t_lo + 1); }
    float il1[2] = {0.f, 0.f};
    if (MODE == 1) {
#pragma unroll
        for (int qt = 0; qt < 2; ++qt) il1[qt] = (mrow[qt] > -1e29f && lrow[qt] > 0.f) ? 1.0f / lrow[qt] : 0.f;
    }
#define ATT_BODY(t, bufsel) do { \
        unsigned char* buf = smem + (bufsel) * A_BUFSZ; \
        const bf16_t* sK = (const bf16_t*)buf; const bf16_t* sVt = (const bf16_t*)(buf + A_SVOFF); \
        const int key0 = t * 64; \
        bool need_mask; \
        if (MODE <= 1) need_mask = (16 * (key0 + 63) + 31 > wtok0); \
        else if (MODE == 2) need_mask = (t == qi - 8) || (t == qi); \
        else need_mask = (t == qi); \
        bool rsel[2] = {true, true}; bool both = true; \
        if (MODE == 3) { \
_Pragma("unroll") \
            for (int qt = 0; qt < 2; ++qt) rsel[qt] = ((sSelW[(qt * 4 + (l15 >> 2)) * 4 + (t >> 5)] >> (t & 31)) & 1u) != 0u; \
            both = false; \
        } \
        if (MODE != 3) { \
            f32x4 st[2][4]; \
_Pragma("unroll") \
            for (int qt = 0; qt < 2; ++qt) \
_Pragma("unroll") \
                for (int kt = 0; kt < 4; ++kt) st[qt][kt] = (f32x4){0.f, 0.f, 0.f, 0.f}; \
_Pragma("unroll") \
            for (int kk = 0; kk < 4; ++kk) { \
                bf16x8 a4[4]; \
_Pragma("unroll") \
                for (int kt = 0; kt < 4; ++kt) a4[kt] = *(const bf16x8*)(sK + (kt * 16 + l15) * SKP + kk * 32 + quad * 8); \
                __builtin_amdgcn_sched_barrier(0); \
_Pragma("unroll") \
                for (int kt = 0; kt < 4; ++kt) { st[0][kt] = mfma16(a4[kt], qf[0][kk], st[0][kt]); st[1][kt] = mfma16(a4[kt], qf[1][kk], st[1][kt]); } \
                __builtin_amdgcn_sched_barrier(0); \
            } \
            bf16x8 pf[2][2]; \
_Pragma("unroll") \
            for (int qt = 0; qt < 2; ++qt) \
                attn_softmax<MODE>(st[qt], tq[qt], key0, need_mask, rsel[qt], mrow[qt], lrow[qt], o[qt], pf[qt], il1[qt], sImp + (w * 8 + qt * 4 + (l15 >> 2)) * 132, lane); \
            if (MODE != 0) { \
_Pragma("unroll") \
                for (int ks = 0; ks < 2; ++ks) \
_Pragma("unroll") \
                    for (int dh = 0; dh < 2; ++dh) { \
                        bf16x4 lo4[4], hi4[4]; \
_Pragma("unroll") \
                        for (int di = 0; di < 4; ++di) { const bf16x8 vv = *(const bf16x8*)(sVt + ((dh * 4 + di) * 16 + l15) * SVP + ks * 32 + quad * 8); lo4[di] = (bf16x4){vv[0], vv[1], vv[2], vv[3]}; hi4[di] = (bf16x4){vv[4], vv[5], vv[6], vv[7]}; } \
                        __builtin_amdgcn_sched_barrier(0); \
_Pragma("unroll") \
                        for (int di = 0; di < 4; ++di) { const int dt = dh * 4 + di; \
                            const bf16x8 a = {lo4[di][0], lo4[di][1], lo4[di][2], lo4[di][3], hi4[di][0], hi4[di][1], hi4[di][2], hi4[di][3]}; \
                            o[0][dt] = mfma16(a, pf[0][ks], o[0][dt]); \
                            o[1][dt] = mfma16(a, pf[1][ks], o[1][dt]); } \
                        __builtin_amdgcn_sched_barrier(0); \
                    } \
            } \
        } else if (both) { \
            bf16x8 pf[2][2]; \
_Pragma("unroll") \
            for (int qt = 0; qt < 2; ++qt) { \
                f32x4 st[4]; bf16x8 ap[2][4]; bf16x4 vlo[2][4], vhi[2][4]; \
_Pragma("unroll") \
                for (int kt = 0; kt < 4; ++kt) st[kt] = (f32x4){0.f, 0.f, 0.f, 0.f}; \
_Pragma("unroll") \
                for (int kk = 0; kk < 4; ++kk) { \
                    if (kk == 0) { \
_Pragma("unroll") \
                        for (int kt = 0; kt < 4; ++kt) ap[0][kt] = *(const bf16x8*)(sK + (kt * 16 + l15) * SKP + quad * 8); } \
                    if (kk + 1 < 4) { \
_Pragma("unroll") \
                        for (int kt = 0; kt < 4; ++kt) ap[(kk + 1) & 1][kt] = *(const bf16x8*)(sK + (kt * 16 + l15) * SKP + (kk + 1) * 32 + quad * 8); } \
                    __builtin_amdgcn_sched_barrier(0); \
_Pragma("unroll") \
                    for (int kt = 0; kt < 4; ++kt) st[kt] = mfma16(ap[kk & 1][kt], qf[qt][kk], st[kt]); \
                    __builtin_amdgcn_sched_barrier(0); \
                } \
                attn_softmax<MODE>(st, tq[qt], key0, need_mask, rsel[qt], mrow[qt], lrow[qt], o[qt], pf[qt], 0.f, sImp, lane); \
            } \
_Pragma("unroll") \
            for (int dt = 0; dt < 8; ++dt) \
_Pragma("unroll") \
                for (int ks = 0; ks < 2; ++ks) { \
                    const bf16_t* vp = sVt + (dt * 16 + l15) * SVP + ks * 32 + quad * 4; \
                    const bf16x4 lo = *(const bf16x4*)vp, hi = *(const bf16x4*)(vp + 16); \
                    const bf16x8 a = {lo[0], lo[1], lo[2], lo[3], hi[0], hi[1], hi[2], hi[3]}; \
                    o[0][dt] = mfma16(a, pf[0][ks], o[0][dt]); \
                    o[1][dt] = mfma16(a, pf[1][ks], o[1][dt]); \
                } \
        } else { \
_Pragma("unroll") \
            for (int qt = 0; qt < 2; ++qt) { \
                const bool rowsel = rsel[qt]; \
                if (__any((int)rowsel) == 0) continue; \
                f32x4 st[4]; bf16x8 ap[2][4]; bf16x4 vlo[2][4], vhi[2][4]; \
_Pragma("unroll") \
                for (int kt = 0; kt < 4; ++kt) st[kt] = (f32x4){0.f, 0.f, 0.f, 0.f}; \
_Pragma("unroll") \
                for (int kk = 0; kk < 4; ++kk) { \
                    if (kk == 0) { \
_Pragma("unroll") \
                        for (int kt = 0; kt < 4; ++kt) ap[0][kt] = *(const bf16x8*)(sK + (kt * 16 + l15) * SKP + quad * 8); } \
                    if (kk + 1 < 4) { \
_Pragma("unroll") \
                        for (int kt = 0; kt < 4; ++kt) ap[(kk + 1) & 1][kt] = *(const bf16x8*)(sK + (kt * 16 + l15) * SKP + (kk + 1) * 32 + quad * 8); } \
                    __builtin_amdgcn_sched_barrier(0); \
_Pragma("unroll") \
                    for (int kt = 0; kt < 4; ++kt) st[kt] = mfma16(ap[kk & 1][kt], qf[qt][kk], st[kt]); \
                    __builtin_amdgcn_sched_barrier(0); \
                } \
                bf16x8 pf[2]; \
_Pragma("unroll") \
                for (int di = 0; di < 4; ++di) { const bf16x8 vv = *(const bf16x8*)(sVt + (di * 16 + l15) * SVP + quad * 8); vlo[0][di] = (bf16x4){vv[0], vv[1], vv[2], vv[3]}; vhi[0][di] = (bf16x4){vv[4], vv[5], vv[6], vv[7]}; } \
                __builtin_amdgcn_sched_barrier(0); \
                attn_softmax<MODE>(st, tq[qt], key0, need_mask, rowsel, mrow[qt], lrow[qt], o[qt], pf, 0.f, sImp, lane); \
_Pragma("unroll") \
                for (int gq = 0; gq < 4; ++gq) { \
                    if (gq + 1 < 4) { \
_Pragma("unroll") \
                        for (int di = 0; di < 4; ++di) { const bf16x8 vv = *(const bf16x8*)(sVt + ((((gq + 1) & 1) * 4 + di) * 16 + l15) * SVP + ((gq + 1) >> 1) * 32 + quad * 8); vlo[(gq + 1) & 1][di] = (bf16x4){vv[0], vv[1], vv[2], vv[3]}; vhi[(gq + 1) & 1][di] = (bf16x4){vv[4], vv[5], vv[6], vv[7]}; } } \
                    __builtin_amdgcn_sched_barrier(0); \
_Pragma("unroll") \
                    for (int di = 0; di < 4; ++di) { const int dt = (gq & 1) * 4 + di; \
                        const bf16x8 a = {vlo[gq & 1][di][0], vlo[gq & 1][di][1], vlo[gq & 1][di][2], vlo[gq & 1][di][3], vhi[gq & 1][di][0], vhi[gq & 1][di][1], vhi[gq & 1][di][2], vhi[gq & 1][di][3]}; \
                        o[qt][dt] = mfma16(a, pf[gq >> 1], o[qt][dt]); } \
                    __builtin_amdgcn_sched_barrier(0); \
                } \
            } \
        } \
 \
} while (0)
    if (DEEP) {
        for (int t0 = t_lo; t0 < t_hi; t0 += 2) {
            { const int t = t0; ATT_BODY(t, 0);
              if (t + 1 < t_hi) ATT_WRITE(kregB, vregB, smem + A_BUFSZ); __syncthreads(); if (t + 3 < t_hi) ATT_LOAD(kregB, vregB, t + 3); }
            if (t0 + 1 < t_hi) { const int t = t0 + 1; ATT_BODY(t, 1);
              if (t + 1 < t_hi) ATT_WRITE(kregA, vregA, smem); __syncthreads(); if (t + 3 < t_hi) ATT_LOAD(kregA, vregA, t + 3); }
        }
    } else {
        for (int t = t_lo; t < t_hi; ++t) {
            const int bs = (t - t_lo) & 1; ATT_BODY(t, bs);
            if (t + 1 < t_hi) ATT_WRITE(kregA, vregA, smem + (bs ^ 1) * A_BUFSZ); __syncthreads(); if (t + 2 < t_hi) ATT_LOAD(kregA, vregA, t + 2);
        }
    }
#undef ATT_BODY
#undef ATT_LOAD
#undef ATT_WRITE
}

template <int BR>
__device__ __forceinline__ void attn_acc(const f32x4 (&o)[2][8], const float (&lrow)[2], bool normalised, const float (&gate)[2], bf16_t* acc, int l15, int quad) {
#pragma unroll
    for (int qt = 0; qt < 2; ++qt) {
        const float f = gate[qt] * (normalised ? 1.0f : (lrow[qt] > 0.f ? 1.0f / lrow[qt] : 0.f));
#pragma unroll
        for (int dt = 0; dt < 8; ++dt) {
            bf16_t* ap = acc + (qt * 16 + l15) * 136 + dt * 16 + quad * 4;
            f32x4 v = o[qt][dt] * f;
            if (BR != 0) { const u32x2 old = *(const u32x2*)ap; v[0] += bflo(old.x); v[1] += bfhi(old.x); v[2] += bflo(old.y); v[3] += bfhi(old.y); }
            u32x2 wv; wv.x = cvt_pk_bf16(v[0], v[1]); wv.y = cvt_pk_bf16(v[2], v[3]); *(u32x2*)ap = wv;
        }
    }
}
template <int SKIPM>
__device__ __forceinline__ void attn_item(const Params& p, int bg, int qi, unsigned char* smem) {
    const int tid = get_tid(), lane = tid & 63, w = tid >> 6, l15 = lane & 15, quad = lane >> 4;
    const int b = bg >> 2, g = bg & 3, s0 = qi * 64, head = g * 4 + (l15 & 3), wtok0 = s0 + 8 * w, cur = qi;
    unsigned char* ws = p.ws;
    const bf16_t* proj = (const bf16_t*)(ws + WS_PROJ); bf16_t* obuf = (bf16_t*)(ws + WS_OBUF);
    float* sImp = (float*)(smem + A_IMP); unsigned long long* sSel = (unsigned long long*)(smem + A_SEL); bf16_t* acc = (bf16_t*)(smem + A_ACC + w * A_ACCW);
    TMR_BEGIN(4)
    const int tq[2] = {wtok0 + (l15 >> 2), wtok0 + 4 + (l15 >> 2)};
    bf16x8 qf[2][4];
#pragma unroll
    for (int qt = 0; qt < 2; ++qt)
#pragma unroll
        for (int kk = 0; kk < 4; ++kk) { const u32x4 raw = *(const u32x4*)(proj + (size_t)(b * SEQ + tq[qt]) * NSA_NP + Q0 + head * 128 + kk * 32 + quad * 8);
            u32x4 sc; sc.x = cvt_pk_bf16(bflo(raw.x) * ATT_C2, bfhi(raw.x) * ATT_C2); sc.y = cvt_pk_bf16(bflo(raw.y) * ATT_C2, bfhi(raw.y) * ATT_C2);
            sc.z = cvt_pk_bf16(bflo(raw.z) * ATT_C2, bfhi(raw.z) * ATT_C2); sc.w = cvt_pk_bf16(bflo(raw.w) * ATT_C2, bfhi(raw.w) * ATT_C2);
            qf[qt][kk] = *reinterpret_cast<bf16x8*>(&sc); }
    float gcmp[2], gsel[2], gwin[2];
#pragma unroll
    for (int qt = 0; qt < 2; ++qt) { const bf16_t* gp = proj + (size_t)(b * SEQ + tq[qt]) * NSA_NP + GL0 + head; gcmp[qt] = bf2f(gp[0]); gsel[qt] = bf2f(gp[16]); gwin[qt] = bf2f(gp[32]); }
    __syncthreads();
    for (int i = tid; i < 64 * 132; i += NTHR) sImp[i] = 0.f;
    float mrow[2], lrow[2]; f32x4 o[2][8];
    unsigned long long selm[2][2] = {{0ull, 0ull}, {0ull, 0ull}};
    const bf16_t* projb = proj + (size_t)b * SEQ * NSA_NP;
    {
        const bf16_t* kc = (const bf16_t*)(ws + WS_KCMP) + (size_t)bg * 512 * 128; const bf16_t* vct = (const bf16_t*)(ws + WS_VCMPT) + (size_t)bg * 128 * 512;
        const int nmax = (s0 + 32) / 16, nt = nmax / 64 + 1;
        mrow[0] = mrow[1] = -1e30f; lrow[0] = lrow[1] = 0.f;
#pragma unroll
        for (int qt = 0; qt < 2; ++qt)
#pragma unroll
            for (int dt = 0; dt < 8; ++dt) o[qt][dt] = (f32x4){0.f, 0.f, 0.f, 0.f};
        if (!(SKIPM & 1)) {
        TMR_BEGIN(0)
        attn_branch<0>(kc, 128, vct, 64, 512, 0, nt, qf, tq, mrow, lrow, o, selm, smem, wtok0, qi);
        TMR_END(0)
        TMR_BEGIN(1)
        attn_branch<1>(kc, 128, vct, 64, 512, 0, nt, qf, tq, mrow, lrow, o, selm, smem, wtok0, qi);
        TMR_END(1)
        }
    }
    __syncthreads();
#pragma unroll 1
    for (int i = 0; i < 8; ++i) {
        const int tl = w * 8 + i;
        unsigned key[2];
#pragma unroll
        for (int h = 0; h < 2; ++h) {
            const int k = lane + 64 * h; const float v = sImp[tl * 132 + k];
            const bool valid = k <= cur, forced = (k == 0) || (k == cur) || (k == cur - 1);
            key[h] = valid ? (forced ? 0xFFFFFFFFu : (__float_as_uint(fmaxf(v, 0.f)) + 1u)) : 0u;
        }
        unsigned prefix = 0u; int need = 16;
#pragma unroll 1
        for (int bit = 31; bit >= 0; --bit) {
            const unsigned mhi = bit == 31 ? 0u : (0xFFFFFFFFu << (bit + 1));
            const bool c0 = ((key[0] & mhi) == prefix) && ((key[0] >> bit) & 1u);
            const bool c1 = ((key[1] & mhi) == prefix) && ((key[1] >> bit) & 1u);
            const int cnt = __popcll(__ballot(c0)) + __popcll(__ballot(c1));
            if (cnt >= need) prefix |= (1u << bit); else need -= cnt;
        }
        const unsigned long long beq0 = __ballot(key[0] == prefix), beq1 = __ballot(key[1] == prefix);
        const unsigned long long lt = (1ull << lane) - 1ull;
        const int r0 = __popcll(beq0 & lt), r1 = __popcll(beq0) + __popcll(beq1 & lt);
        const bool s0 = (key[0] > prefix) || (key[0] == prefix && r0 < need);
        const bool s1 = (key[1] > prefix) || (key[1] == prefix && r1 < need);
        const unsigned long long b0 = __ballot(s0), b1 = __ballot(s1);
        if (lane == 0) { sSel[tl * 2] = b0; sSel[tl * 2 + 1] = b1; }
    }
    __syncthreads();
    attn_acc<0>(o, lrow, true, gcmp, acc, l15, quad);
    {
        mrow[0] = mrow[1] = -1e30f; lrow[0] = lrow[1] = 0.f;
#pragma unroll
        for (int qt = 0; qt < 2; ++qt)
#pragma unroll
            for (int dt = 0; dt < 8; ++dt) o[qt][dt] = (f32x4){0.f, 0.f, 0.f, 0.f};
        const int t_lo = qi - 8 > 0 ? qi - 8 : 0;
#if (ATT_REPEAT & 2)
        attn_branch<2>(projb + KW0 + g * 128, NSA_NP, (const bf16_t*)(ws + WS_VWT) + (size_t)bg * 128 * SEQ, 64, SEQ, t_lo, qi + 1, qf, tq, mrow, lrow, o, selm, smem, wtok0, qi);
        mrow[0] = mrow[1] = -1e30f; lrow[0] = lrow[1] = 0.f;
#pragma unroll
        for (int qt = 0; qt < 2; ++qt)
#pragma unroll
            for (int dt = 0; dt < 8; ++dt) o[qt][dt] = (f32x4){0.f, 0.f, 0.f, 0.f};
#endif
        TMR_BEGIN(2)
        if (!(SKIPM & 2))
        attn_branch<2>(projb + KW0 + g * 128, NSA_NP, (const bf16_t*)(ws + WS_VWT) + (size_t)bg * 128 * SEQ, 64, SEQ, t_lo, qi + 1, qf, tq, mrow, lrow, o, selm, smem, wtok0, qi);
        TMR_END(2)
        attn_acc<1>(o, lrow, false, gwin, acc, l15, quad);
    }
    {
        mrow[0] = mrow[1] = -1e30f; lrow[0] = lrow[1] = 0.f;
#pragma unroll
        for (int qt = 0; qt < 2; ++qt)
#pragma unroll
            for (int dt = 0; dt < 8; ++dt) o[qt][dt] = (f32x4){0.f, 0.f, 0.f, 0.f};
#if (ATT_REPEAT & 4)
        attn_branch<3>(projb + KS0 + g * 128, NSA_NP, (const bf16_t*)(ws + WS_VST) + (size_t)bg * 128 * SEQ, 64, SEQ, 0, cur + 1, qf, tq, mrow, lrow, o, selm, smem, wtok0, qi);
        mrow[0] = mrow[1] = -1e30f; lrow[0] = lrow[1] = 0.f;
#pragma unroll
        for (int qt = 0; qt < 2; ++qt)
#pragma unroll
            for (int dt = 0; dt < 8; ++dt) o[qt][dt] = (f32x4){0.f, 0.f, 0.f, 0.f};
#endif
        TMR_BEGIN(3)
        if (!(SKIPM & 4))
        attn_branch<3>(projb + KS0 + g * 128, NSA_NP, (const bf16_t*)(ws + WS_VST) + (size_t)bg * 128 * SEQ, 64, SEQ, 0, cur + 1, qf, tq, mrow, lrow, o, selm, smem, wtok0, qi);
        TMR_END(3)
        attn_acc<1>(o, lrow, false, gsel, acc, l15, quad);
    }
    asm volatile("s_waitcnt lgkmcnt(0)" ::: "memory");
#pragma unroll
    for (int i = 0; i < 8; ++i) {
        const int row = i * 4 + quad, c8 = l15 * 8, tok = wtok0 + 4 * (row >> 4) + ((row & 15) >> 2), hd = g * 4 + (row & 3);
        const u32x4 a = *(const u32x4*)(acc + row * 136 + c8);
        const u32x4 z = *(const u32x4*)(proj + (size_t)(b * SEQ + tok) * NSA_NP + Z0 + hd * 128 + c8);
        u32x4 r; r.x = cvt_pk_bf16(bflo(a.x) * bflo(z.x), bfhi(a.x) * bfhi(z.x)); r.y = cvt_pk_bf16(bflo(a.y) * bflo(z.y), bfhi(a.y) * bfhi(z.y));
        r.z = cvt_pk_bf16(bflo(a.z) * bflo(z.z), bfhi(a.z) * bfhi(z.z)); r.w = cvt_pk_bf16(bflo(a.w) * bflo(z.w), bfhi(a.w) * bfhi(z.w));
        *(u32x4*)(obuf + (size_t)(b * SEQ + tok) * DM + hd * 128 + c8) = r;
    }
    __syncthreads();
    TMR_END(4)
}
constexpr int H_G = 0;
constexpr int H_TOT = 16384;
constexpr int H_DEC = 18432;
constexpr int H_QB = 18944;
constexpr int H_KM = 27648;
constexpr int H_KBT = 36352;
constexpr int H_IT = 46592;
constexpr int H_ATT = 56832;
constexpr int H_O = 59392;
template <int PASS>
__device__ __forceinline__ void hgrn_item(const Params& p, int hl, int item, unsigned char* smem) {
    const int tid = get_tid(), lane = tid & 63, w = tid >> 6, l15 = lane & 15, quad = lane >> 4;
    const int bh = item >> 3, seg = item & 7, b = bh >> 4, h = bh & 15;
    unsigned char* ws = p.ws;
    const bf16_t* proj = (const bf16_t*)(ws + WS_PROJ); bf16_t* obuf = (bf16_t*)(ws + WS_OBUF);
    float* hseg = (float*)(ws + WS_HSEG);
    float* sTot = (float*)(smem + H_TOT); float* sDec = (float*)(smem + H_DEC);
    bf16_t* sQb = (bf16_t*)(smem + H_QB); bf16_t* sKm = (bf16_t*)(smem + H_KM); bf16_t* sKbT = (bf16_t*)(smem + H_KBT); bf16_t* sIT = (bf16_t*)(smem + H_IT);
    bf16_t* sAtt = (bf16_t*)(smem + H_ATT); float* sO = (float*)(smem + H_O);
    const int d = tid & 127, tqr = tid >> 7;
    const size_t tokbase = (size_t)b * SEQ + (size_t)seg * 1024;
    const bf16_t* pq = proj + tokbase * HG_NP + h * 128 + d;
    f32x4 S[8];
#pragma unroll
    for (int dt = 0; dt < 8; ++dt) S[dt] = (f32x4){0.f, 0.f, 0.f, 0.f};
    if (PASS == 1) {
        for (int sj = 0; sj < seg; ++sj) {
            const float* U = hseg + (size_t)(bh * 8 + sj) * HSEG_STRIDE; const float* Dv = U + 128 * 128;
#pragma unroll
            for (int dt = 0; dt < 8; ++dt)
#pragma unroll
                for (int j = 0; j < 4; ++j) { const int dd = dt * 16 + quad * 4 + j; S[dt][j] = S[dt][j] * Dv[dd] + U[dd * 128 + 16 * w + l15]; }
        }
    }
    float gtot = 0.f;
    const int gt = tid >> 4, gi8 = (tid & 15) * 8;
    f32x4 gw0 = {1.f, 1.f, 1.f, 1.f}, gw1 = gw0; u32x4 zreg = {0u, 0u, 0u, 0u};
    if (PASS == 1) { const float* gwp = p.hg_gn + hl * 128 + gi8; gw0 = *(const f32x4*)gwp; gw1 = *(const f32x4*)(gwp + 4);
        zreg = *(const u32x4*)(proj + (tokbase + gt) * HG_NP + 6144 + h * 128 + gi8); }
    bf16_t rg[8], ri[8], rq[8];
#pragma unroll
    for (int j = 0; j < 8; ++j) { const bf16_t* pc = pq + (size_t)(tqr * 8 + j) * HG_NP; rg[j] = pc[2048]; ri[j] = pc[4096]; rq[j] = PASS == 1 ? pc[0] : (bf16_t)0; }
    for (int c = 0; c < 32; ++c) {
        float g8[8], q8[8], i8[8];
#pragma unroll
        for (int j = 0; j < 8; ++j) { g8[j] = bf2f(rg[j]); i8[j] = bf2f(ri[j]); q8[j] = PASS == 1 ? bf2f(rq[j]) : 0.f; }
        float cs[8]; cs[0] = g8[0];
#pragma unroll
        for (int j = 1; j < 8; ++j) cs[j] = cs[j - 1] + g8[j];
        sTot[tqr * 128 + d] = cs[7];
        __syncthreads();
        float off = 0.f, bl = 0.f;
#pragma unroll
        for (int q = 0; q < 4; ++q) { const float tv = sTot[q * 128 + d]; bl += tv; if (q < tqr) off += tv; }
        { float kb[8], iv[8];
#pragma unroll
          for (int j = 0; j < 8; ++j) {
              const float bt = off + cs[j];
              const float kk = 1.0f - __expf(g8[j]);
              kb[j] = kk * __expf(bl - bt); iv[j] = i8[j];
              if (PASS == 1) {
                  const int t = tqr * 8 + j;
                  sQb[t * 136 + d] = (bf16_t)cvt_pk_bf16(q8[j] * __expf(bt), 0.f);
                  sKm[t * 136 + d] = (bf16_t)cvt_pk_bf16(kk * __expf(fminf(-bt, 80.f)), 0.f);
              }
          }
          *(bf16x8*)(sKbT + d * 40 + tqr * 8) = pack8f(kb);
          *(bf16x8*)(sIT + d * 40 + tqr * 8) = pack8f(iv); }
        if (tqr == 0) { sDec[d] = __expf(bl); gtot += bl; }
        __syncthreads();
        if (c + 1 < 32) {
#pragma unroll
            for (int j = 0; j < 8; ++j) { const bf16_t* pc = pq + (size_t)((c + 1) * 32 + tqr * 8 + j) * HG_NP; rg[j] = pc[2048]; ri[j] = pc[4096]; if (PASS == 1) rq[j] = pc[0]; }
        }
        u32x4 znext = zreg; if (PASS == 1 && c + 1 < 32) znext = *(const u32x4*)(proj + (tokbase + (c + 1) * 32 + gt) * HG_NP + 6144 + h * 128 + gi8);
        const bf16x8 ifr = *(const bf16x8*)(sIT + (16 * w + l15) * 40 + quad * 8);
        f32x4 oacc[2] = {{0.f, 0.f, 0.f, 0.f}, {0.f, 0.f, 0.f, 0.f}};
        if (PASS == 1) {
            if (w < 4) {
                const int rt = w >> 1, ct = w & 1; f32x4 a4 = {0.f, 0.f, 0.f, 0.f};
#pragma unroll
                for (int kk = 0; kk < 4; ++kk) {
                    const bf16x8 a = *(const bf16x8*)(sQb + (rt * 16 + l15) * 136 + kk * 32 + quad * 8);
                    const bf16x8 bb = *(const bf16x8*)(sKm + (ct * 16 + l15) * 136 + kk * 32 + quad * 8);
                    a4 = mfma16(a, bb, a4);
                }
#pragma unroll
                for (int j = 0; j < 4; ++j) { const int t = rt * 16 + quad * 4 + j, s = ct * 16 + l15; sAtt[t * 40 + s] = (bf16_t)cvt_pk_bf16(s <= t ? a4[j] : 0.f, 0.f); }
            }
#pragma unroll
            for (int kk = 0; kk < 4; ++kk) {
                const bf16x8 bs = pack44(S[2 * kk], S[2 * kk + 1]);
#pragma unroll
                for (int rt = 0; rt < 2; ++rt) {
                    const bf16_t* qp = sQb + (rt * 16 + l15) * 136 + kk * 32 + quad * 4;
                    const bf16x4 lo = *(const bf16x4*)qp, hi = *(const bf16x4*)(qp + 16);
                    const bf16x8 a = {lo[0], lo[1], lo[2], lo[3], hi[0], hi[1], hi[2], hi[3]};
                    oacc[rt] = mfma16(a, bs, oacc[rt]);
                }
            }
        }
#pragma unroll
        for (int dt = 0; dt < 8; ++dt) {
            const f32x4 dc = *(const f32x4*)(sDec + dt * 16 + quad * 4);
            const bf16x8 a = *(const bf16x8*)(sKbT + (dt * 16 + l15) * 40 + quad * 8);
            S[dt] = mfma16(a, ifr, S[dt] * dc);
        }
        if (PASS == 1) {
            __syncthreads();
#pragma unroll
            for (int rt = 0; rt < 2; ++rt) { const bf16x8 a = *(const bf16x8*)(sAtt + (rt * 16 + l15) * 40 + quad * 8); oacc[rt] = mfma16(a, ifr, oacc[rt]); }
#pragma unroll
            for (int rt = 0; rt < 2; ++rt)
#pragma unroll
                for (int j = 0; j < 4; ++j) sO[(rt * 16 + quad * 4 + j) * 132 + 16 * w + l15] = oacc[rt][j];
            __syncthreads();
            { const int t = tid >> 4, i8c = (tid & 15) * 8; float v[8]; float ss = 0.f;
              const f32x4 a0 = *(const f32x4*)(sO + t * 132 + i8c), a1 = *(const f32x4*)(sO + t * 132 + i8c + 4);
#pragma unroll
              for (int j = 0; j < 4; ++j) { v[j] = a0[j]; v[4 + j] = a1[j]; }
#pragma unroll
              for (int j = 0; j < 8; ++j) ss += v[j] * v[j];
              ss = row16_sum(ss);
              const float rinv = rsqrtf(ss * (1.0f / 128.0f) + RMS_EPS);
              const size_t tok = tokbase + c * 32 + t;
              const u32x4 z = zreg; const f32x4 g0 = gw0, g1 = gw1;
              v[0] *= rinv * g0[0] * bflo(z.x); v[1] *= rinv * g0[1] * bfhi(z.x); v[2] *= rinv * g0[2] * bflo(z.y); v[3] *= rinv * g0[3] * bfhi(z.y);
              v[4] *= rinv * g1[0] * bflo(z.z); v[5] *= rinv * g1[1] * bfhi(z.z); v[6] *= rinv * g1[2] * bflo(z.w); v[7] *= rinv * g1[3] * bfhi(z.w);
              *(bf16x8*)(obuf + tok * DM + h * 128 + i8c) = pack8f(v); }
            zreg = znext;
        }
    }
    if (PASS == 0) {
        float* U = hseg + (size_t)(bh * 8 + seg) * HSEG_STRIDE;
#pragma unroll
        for (int dt = 0; dt < 8; ++dt)
#pragma unroll
            for (int j = 0; j < 4; ++j) U[(dt * 16 + quad * 4 + j) * 128 + 16 * w + l15] = S[dt][j];
        if (tqr == 0) U[128 * 128 + d] = __expf(gtot);
    }
    __syncthreads();
}

#define XB_TMO      128
#define XB_XCNT(j)  (256  + 64 * (j))
#define XB_XSUB(j)  (1280 + 64 * (j))
#define XB_XGEN(j)  (2304 + 64 * (j))
#define XB_TOP      3328
#define XB_TOPGEN   3392
#define XCD_BAR_WORDS 3456
#define XB_SPIN_CAP (1u << 18)
#define XLAS __attribute__((address_space(3)))

__device__ __forceinline__ unsigned xb_ld(unsigned* p)              { return __hip_atomic_load(p, __ATOMIC_RELAXED, __HIP_MEMORY_SCOPE_AGENT); }
__device__ __forceinline__ unsigned xb_add(unsigned* p, unsigned v) { return __hip_atomic_fetch_add(p, v, __ATOMIC_RELAXED, __HIP_MEMORY_SCOPE_AGENT); }
__device__ __forceinline__ unsigned xb_xcc_id() { return (unsigned)__builtin_amdgcn_s_getreg((3 << 11) | 20) & 0xFu; }
#define XB_SPIN(cond, bar) do { unsigned _sp = 0; while (cond) { __builtin_amdgcn_s_sleep(1); \
    if ((++_sp & 255u) == 0u) { if (xb_ld(&(bar)[XB_TMO])) break; if (_sp > XB_SPIN_CAP) { atomicAdd(&(bar)[XB_TMO], 1u); break; } } } } while (0)

struct XcdBarrier {
    unsigned* bar; unsigned x;
    volatile XLAS unsigned* st;
};

__device__ __forceinline__ XcdBarrier xcd_barrier_post(unsigned* bar, volatile XLAS unsigned* st) {
    XcdBarrier b; b.bar = bar; b.x = xb_xcc_id(); b.st = st;
    if (threadIdx.x == 0) (void)xb_add(&bar[XB_XCNT(b.x)], 1u);
    return b;
}
__device__ __forceinline__ void xcd_barrier_complete(unsigned* bar, unsigned x, unsigned& nloc, unsigned& nx) {
    const unsigned G = gridDim.x * gridDim.y * gridDim.z;
    unsigned sum, cnt, mine, sp = 0u;
    for (;;) {
        sum = 0u; cnt = 0u; mine = 0u;
#pragma unroll
        for (unsigned j = 0; j < 16; ++j) { const unsigned c = xb_ld(&bar[XB_XCNT(j)]); sum += c; cnt += (c > 0u) ? 1u : 0u; mine = (j == x) ? c : mine; }
        if (sum == G) break;
        __builtin_amdgcn_s_sleep(1);
        if ((++sp & 255u) == 0u) { if (xb_ld(&bar[XB_TMO])) break; if (sp > XB_SPIN_CAP) { atomicAdd(&bar[XB_TMO], 1u); break; } }
    }
    nloc = mine > 0u ? mine : 1u; nx = cnt > 0u ? cnt : 1u;
}

__device__ __forceinline__ void xcd_barrier(const XcdBarrier& b) {
    asm volatile("s_waitcnt vmcnt(0)" ::: "memory");
    __syncthreads();
    if (threadIdx.x == 0) {
        unsigned* bar = b.bar;
        __builtin_amdgcn_s_waitcnt(0);
        unsigned nloc = b.st[0], nx = b.st[1];
        if (nloc == 0u) { xcd_barrier_complete(bar, b.x, nloc, nx); b.st[0] = nloc; b.st[1] = nx; }
        const unsigned old = xb_add(&bar[XB_XSUB(b.x)], 1u);
        const unsigned gen = old / nloc;
        if (old + 1u == (gen + 1u) * nloc) {
            __builtin_amdgcn_fence(__ATOMIC_RELEASE, "agent");
            asm volatile("s_waitcnt vmcnt(0)" ::: "memory");
            const unsigned og = xb_add(&bar[XB_TOP], 1u);
            const unsigned tg = og / nx;
            if (og + 1u == (tg + 1u) * nx) xb_add(&bar[XB_TOPGEN], 1u);
            else XB_SPIN(xb_ld(&bar[XB_TOPGEN]) == tg, bar);
            __builtin_amdgcn_fence(__ATOMIC_ACQUIRE, "agent");
            xb_add(&bar[XB_XGEN(b.x)], 1u);
            asm volatile("s_waitcnt vmcnt(0)" ::: "memory");
        } else {
            XB_SPIN(xb_ld(&bar[XB_XGEN(b.x)]) == gen, bar);
            __builtin_amdgcn_fence(__ATOMIC_ACQUIRE, "agent");
            asm volatile("s_waitcnt vmcnt(0)" ::: "memory");
        }
    }
    __syncthreads();
}

#ifndef USE_XCD_BARRIER
#define USE_XCD_BARRIER 1
#endif
#ifndef ATT_DYNAMIC
#define ATT_DYNAMIC 0
#endif

#ifndef DEBUG_CENSUS
#define DEBUG_CENSUS 0
#endif
#if DEBUG_CENSUS
__device__ __forceinline__ void scan_bf16(const bf16_t* ptr, size_t n, int code, int* flag) {
    bool bad = false; const size_t st = (size_t)gridDim.x * NTHR;
    for (size_t i = (size_t)blockIdx.x * NTHR + get_tid(); i < n; i += st) bad |= ((ptr[i] & 0x7f80) == 0x7f80);
    if (bad) atomicMin(flag, code);
}
__device__ __forceinline__ void scan_f32(const float* ptr, size_t n, int code, int* flag) {
    bool bad = false; const size_t st = (size_t)gridDim.x * NTHR;
    for (size_t i = (size_t)blockIdx.x * NTHR + get_tid(); i < n; i += st) bad |= ((__float_as_uint(ptr[i]) & 0x7f800000u) == 0x7f800000u);
    if (bad) atomicMin(flag, code);
}
__device__ __noinline__ void census_unused(); __device__ __forceinline__ void census(const Params& p, int ph) {
    unsigned char* ws = p.ws; int* flag = (int*)(ws + WS_CBIAS + 2048);
    const int layer = (ph - 1) >> 2, sub = (ph - 1) & 3; const bool nsa = (layer & 1) == 0;
    if (ph == 0) { scan_bf16((bf16_t*)(ws + WS_XB), (size_t)NTOK * DM, 0, flag); scan_bf16((bf16_t*)(ws + WS_WIN), (size_t)NSA_NP * DM, 1, flag);
        scan_f32((float*)(ws + WS_ROPE), (size_t)NTOK * 32, 2, flag); scan_f32((float*)(ws + WS_CBIAS), 512, 3, flag); scan_f32((float*)(ws + WS_LB), 4096, 4, flag); scan_f32((float*)(ws + WS_SSQ), NTOK, 5, flag);
        scan_bf16((bf16_t*)(ws + WS_W1T), (size_t)4 * 128 * 4096, 6, flag); scan_bf16((bf16_t*)(ws + WS_W2T), (size_t)4 * 128 * 128, 7, flag); }
    else if (ph == 17) {}
    else if (sub == 0) scan_bf16((bf16_t*)(ws + WS_PROJ), (size_t)NTOK * (nsa ? NSA_NP : HG_NP), 8 + 8 * layer + 0, flag);
    else if (sub == 1) { if (nsa) { scan_bf16((bf16_t*)(ws + WS_KCMP), (size_t)8 * 512 * 128, 8 + 8 * layer + 1, flag); scan_bf16((bf16_t*)(ws + WS_VCMPT), (size_t)8 * 512 * 128, 8 + 8 * layer + 2, flag);
                                   scan_bf16((bf16_t*)(ws + WS_VST), (size_t)8 * 128 * SEQ, 8 + 8 * layer + 3, flag); scan_bf16((bf16_t*)(ws + WS_VWT), (size_t)8 * 128 * SEQ, 8 + 8 * layer + 3, flag); }
                         else { for (int it = 0; it < 256; ++it) if ((it & 7) != 7) scan_f32((float*)(ws + WS_HSEG) + (size_t)it * HSEG_STRIDE, HSEG_STRIDE, 8 + 8 * layer + 1, flag); }
                         scan_bf16((bf16_t*)(ws + WS_WOUT), (size_t)DM * DM, 8 + 8 * layer + 4, flag); scan_bf16((bf16_t*)(ws + WS_WIN), (size_t)DM * NSA_NP, 8 + 8 * layer + 4, flag); }
    else if (sub == 2) scan_bf16((bf16_t*)(ws + WS_OBUF), (size_t)NTOK * DM, 8 + 8 * layer + 5, flag);
    else { scan_f32(p.out, (size_t)NTOK * DM, 8 + 8 * layer + 6, flag); scan_f32((float*)(ws + WS_SSQ) + (size_t)(layer + 1) * NTOK, NTOK, 8 + 8 * layer + 7, flag); }
}
#endif
constexpr int N_PHASES = 18;
__global__ void __launch_bounds__(NTHR, 2) fwd_kernel(Params p_in) {
    extern __shared__ __attribute__((aligned(16))) unsigned char smem[];
    const int tid = get_tid();
    float* tile = (float*)smem;
    XcdBarrier xbar; xbar.bar = (unsigned*)(p_in.ws + WS_BAR); xbar.x = 0; xbar.st = (volatile XLAS unsigned*)(smem + LDS_BYTES - 16);
    if (p_in.coop) {
        if (threadIdx.x < 4) ((XLAS unsigned*)(smem + LDS_BYTES - 16))[threadIdx.x] = 0u;
        __syncthreads();
        xbar = xcd_barrier_post((unsigned*)(p_in.ws + WS_BAR), (volatile XLAS unsigned*)(smem + LDS_BYTES - 16));
    }
    const Params& p0 = p_in;
#ifndef REPEAT_MASK
#define REPEAT_MASK 0
#endif
    int rep = 0;
    for (int ph = p0.ph_lo; ph < p0.ph_hi;) {
        Params p = p0;
        unsigned char* ws = p.ws; int blk = blockIdx.x, nblk = gridDim.x;
        asm volatile("" : "+s"(ws), "+s"(blk), "+s"(nblk));
        p.ws = ws;
        bf16_t* Win = (bf16_t*)(ws + WS_WIN); bf16_t* Wout = (bf16_t*)(ws + WS_WOUT);
        bf16_t* xb = (bf16_t*)(ws + WS_XB); bf16_t* proj = (bf16_t*)(ws + WS_PROJ); bf16_t* obuf = (bf16_t*)(ws + WS_OBUF);
        float* ssq = (float*)(ws + WS_SSQ);
        if (ph == 0) phase_prep(p, smem);
#if DEBUG_TIMER
        else if (ph == 17) { const size_t st = (size_t)nblk * NTHR; for (size_t i = (size_t)blk * NTHR + tid; i < (size_t)NTOK * DM; i += st) p.out[i] = 0.f;
            if (blk == 0 && tid == 0) { const unsigned long long c = *(unsigned long long*)(ws + WS_CBIAS + 2048 + 16); p.out[0] = (float)c * 0.01f * 100.f; } }
#endif
#if DEBUG_CENSUS
        else if (ph == 17) { const size_t st = (size_t)nblk * NTHR; for (size_t i = (size_t)blk * NTHR + tid; i < (size_t)NTOK * DM; i += st) p.out[i] = 0.f;
            if (blk == 0 && tid == 0) { int c = *(int*)(ws + WS_CBIAS + 2048); if (c > 80) c = 80; p.out[0] = (10.f + (float)c) * 1000.f; } }
#endif
        else if (ph == 17) {
            const int lane = tid & 63, wave = tid >> 6;
            for (int row = blk * 8 + wave; row < NTOK; row += nblk * 8) {
                const float rs = rsqrtf(ssq[4 * NTOK + row] * (1.0f / 2048.0f) + RMS_EPS); float* xr = p.out + (size_t)row * DM;
#pragma unroll
                for (int i = 0; i < 8; ++i) { const int c = (i * 64 + lane) * 4; f32x4 v = *(const f32x4*)(xr + c); const f32x4 wv = *(const f32x4*)(p.fnorm_w + c); v = v * rs * wv;
#if SANITIZE
                    for (int e = 0; e < 4; ++e) if (!(fabsf(v[e]) < 1e30f)) v[e] = 0.f;
#endif
                    *(f32x4*)(xr + c) = v; }
            }
        } else {
            const int layer = (ph - 1) >> 2, sub = (ph - 1) & 3, j = layer >> 1; const bool nsa = (layer & 1) == 0;
            if (sub == 0) {
#if (REPEAT_MASK & 64)
                if (rep == 0) { pg8::Gemm g{xb, Win, NTOK, nsa ? NSA_NP : HG_NP, DM}; pg8::StaticOrder S; S.init(NTOK, nsa ? NSA_NP : HG_NP, nblk, blk);
                    EpiPlain E{proj, nsa ? NSA_NP : HG_NP};
                    pg8::gemm_phase<EpiPlain, pg8::StaticOrder, false>((PG8_LAS unsigned char*)smem, g, S, E, nullptr); }
                else
#endif
                if (nsa) { pg8::Gemm g{xb, Win, NTOK, NSA_NP, DM}; pg8::StaticOrder S; S.init(NTOK, NSA_NP, nblk, blk);
                    EpiNsaIn E{proj, ssq + (size_t)layer * NTOK, (const float*)(ws + WS_ROPE)};
                    pg8::gemm_phase<EpiNsaIn, pg8::StaticOrder, false>((PG8_LAS unsigned char*)smem, g, S, E, nullptr);
                    const int rem = ((NTOK / 256) * (NSA_NP / 256)) % nblk;
                    if (rem != 0 && blk >= rem) {
                        tconv<0>(p.nsa_w_out + (size_t)j * DM * DM, DM, DM, Wout, DM, DM, nullptr, tile, blk - rem, nblk - rem);
                        tconv<0>(p.hg_w_in + (size_t)j * DM * HG_NP, HG_NP, HG_NP, (bf16_t*)(ws + WS_WIN2), DM, HG_NP, p.norm_w + (size_t)(layer + 1) * DM, tile, blk - rem, nblk - rem);
                    } }
                else { pg8::Gemm g{xb, (bf16_t*)(ws + WS_WIN2), NTOK, HG_NP, DM}; pg8::StaticOrder S; S.init(NTOK, HG_NP, nblk, blk);
                    EpiHgIn E{proj, ssq + (size_t)layer * NTOK, (const float*)(ws + WS_LB) + j * 2048};
                    pg8::gemm_phase<EpiHgIn, pg8::StaticOrder, false>((PG8_LAS unsigned char*)smem, g, S, E, nullptr); }
            } else if (sub == 1) {
                if (nsa) {
                    for (int it = blk; it < 256; it += nblk) compress_item(p, j, it, smem);
                    for (int it = blk; it < 2048; it += nblk) vtrans_item(p, it, smem);
                    if (((NTOK / 256) * (NSA_NP / 256)) % nblk == 0) {
                        tconv<0>(p.nsa_w_out + (size_t)j * DM * DM, DM, DM, Wout, DM, DM, nullptr, tile, blk, nblk);
                        tconv<0>(p.hg_w_in + (size_t)j * DM * HG_NP, HG_NP, HG_NP, (bf16_t*)(ws + WS_WIN2), DM, HG_NP, p.norm_w + (size_t)(layer + 1) * DM, tile, blk, nblk);
                    }
                } else {
                    for (int it = blk; it < 256; it += nblk) if ((it & 7) != 7) hgrn_item<0>(p, j, it, smem);
                    tconv<0>(p.hg_w_out + (size_t)j * DM * DM, DM, DM, Wout, DM, DM, nullptr, tile, blk, nblk);
                    if (layer + 1 < 4) tconv<1>(p.nsa_w_in + (size_t)(j + 1) * DM * NSA_IN, NSA_IN, NSA_IN, Win, DM, NSA_NP, p.norm_w + (size_t)(layer + 1) * DM, tile, blk, nblk);
                }
            } else if (sub == 2) {
                if (nsa) {
#if ATT_DYNAMIC
                    {
                        unsigned* qhead = (unsigned*)(ws + WS_CBIAS + 2048 + 64) + j; volatile XLAS unsigned* qslot = (volatile XLAS unsigned*)(smem + LDS_BYTES - 32);
                        for (;;) {
                            __syncthreads();
                            if (threadIdx.x == 0) qslot[0] = atomicAdd(qhead, 1u);
                            __syncthreads();
                            const unsigned idx = qslot[0];
                            if (idx >= 1024u) break;
                            attn_item<0>(p, (int)(idx & 7u), 127 - (int)(idx >> 3), smem);
                        }
                    }
#else
                    for (int it = blk; it < 1024; it += nblk) { const int slot = it & 255, rnd = it >> 8, bg = slot & 7, jj = slot >> 3;
                        const int qi = rnd == 0 ? 127 - jj : (rnd == 1 ? 64 + jj : (rnd == 2 ? 63 - jj : jj));
#ifdef ATT_SKELETON_FIRST
                        attn_item<ATT_SKELETON_FIRST>(p, bg, qi, smem);
#endif
                        attn_item<0>(p, bg, qi, smem); }
#endif
                } else {
                    for (int it = blk; it < 256; it += nblk) hgrn_item<1>(p, j, it, smem);
                }
            } else {
                pg8::Gemm g{obuf, Wout, NTOK, DM, DM}; pg8::StaticOrder S; S.init(NTOK, DM, nblk, blk);
                EpiOut E{layer == 0 ? p.x : (const float*)p.out, p.out, xb, ssq + (size_t)(layer + 1) * NTOK};
                pg8::gemm_phase<EpiOut, pg8::StaticOrder, false>((PG8_LAS unsigned char*)smem, g, S, E, nullptr);
            }
        }
#if DEBUG_CENSUS
        if (ph != 17) census(p, ph);
#endif
        { const int sub_ = (ph - 1) & 3, nsa_ = ((((ph - 1) >> 2) & 1) == 0);
          const bool again = REPEAT_MASK != 0 && rep == 0 && ph >= 1 && ph <= 16 && ((sub_ == 0 && nsa_ && (REPEAT_MASK & 1)) || (sub_ == 0 && !nsa_ && (REPEAT_MASK & 2)) || (sub_ == 2 && nsa_ && (REPEAT_MASK & 4)) || (sub_ == 2 && !nsa_ && (REPEAT_MASK & 8)) || (sub_ == 1 && nsa_ && (REPEAT_MASK & 16)) || (sub_ == 1 && !nsa_ && (REPEAT_MASK & 32)) || (sub_ == 0 && (REPEAT_MASK & 64)));
          if (again) rep = 1; else { rep = 0; ++ph; } }
        if (ph < p0.ph_hi) { if (p0.coop) {
#if USE_XCD_BARRIER
            if (ph == 1) cg::this_grid().sync(); else xcd_barrier(xbar);
#else
            cg::this_grid().sync();
#endif
        } }
    }
}

extern "C" void kernel_launch(void* const* d_in, const int* in_sizes, int n_in, void* d_out, int out_size, void* d_ws, size_t ws_size, hipStream_t stream) {
    static int grid = 0;
    if (grid == 0) {
        if (ws_size < WS_END2) { fprintf(stderr, "kernel_launch: workspace too small: %zu < %zu\n", ws_size, (size_t)WS_END2); grid = -1; return; }
        int dev = 0, cus = 0, per_cu = 0;
        hipGetDevice(&dev); hipDeviceGetAttribute(&cus, hipDeviceAttributeMultiprocessorCount, dev);
        if (hipFuncSetAttribute((const void*)fwd_kernel, hipFuncAttributeMaxDynamicSharedMemorySize, LDS_BYTES) != hipSuccess) { fprintf(stderr, "kernel_launch: hipFuncSetAttribute failed\n"); grid = -1; return; }
        if (hipOccupancyMaxActiveBlocksPerMultiprocessor(&per_cu, (const void*)fwd_kernel, NTHR, LDS_BYTES) != hipSuccess || per_cu < 1) { fprintf(stderr, "kernel_launch: occupancy query says %d\n", per_cu); per_cu = 1; }
        (void)hipGetLastError();
        grid = cus * 1;
    }
    if (grid < 0) return;
    Params p{};
    p.x = (const float*)d_in[0]; p.pos = (const int*)d_in[1]; p.norm_w = (const float*)d_in[2]; p.fnorm_w = (const float*)d_in[3];
    p.nsa_w_in = (const float*)d_in[4]; p.ck_pos = (const float*)d_in[5]; p.ck_w1 = (const float*)d_in[6]; p.ck_w2 = (const float*)d_in[7];
    p.cv_pos = (const float*)d_in[8]; p.cv_w1 = (const float*)d_in[9]; p.cv_w2 = (const float*)d_in[10]; p.nsa_w_out = (const float*)d_in[11];
    p.hg_w_in = (const float*)d_in[12]; p.hg_lb = (const float*)d_in[13]; p.hg_gn = (const float*)d_in[14]; p.hg_w_out = (const float*)d_in[15];
    p.out = (float*)d_out; p.ws = (unsigned char*)d_ws;
#if DEBUG_CENSUS
    hipMemsetAsync((unsigned char*)d_ws + WS_CBIAS + 2048, 0x7f, 4, stream);
#endif
#if DEBUG_TIMER
    hipMemsetAsync((unsigned char*)d_ws + WS_CBIAS + 2048 + 16, 0, 8, stream);
#endif
#if ONE_LAUNCH
    hipMemsetAsync((unsigned char*)d_ws + WS_BAR, 0, 16384, stream);
    p.ph_lo = 0; p.ph_hi = N_PHASES; p.coop = 1; p.pad = 0;
    void* args[] = {&p};
    hipError_t e = hipLaunchCooperativeKernel((const void*)fwd_kernel, dim3(grid), dim3(NTHR), args, LDS_BYTES, stream);
    if (e != hipSuccess) fprintf(stderr, "cooperative launch failed: %s (grid %d)\n", hipGetErrorString(e), grid);
#else
    for (int ph = 0; ph < N_PHASES; ++ph) {
#ifdef DBG_LAST_PHASE
        if (ph > DBG_LAST_PHASE && ph != 17) continue;
#endif
        p.ph_lo = ph; p.ph_hi = ph + 1; p.coop = 0; p.pad = 0;
        hipLaunchKernelGGL(fwd_kernel, dim3(grid), dim3(NTHR), LDS_BYTES, stream, p);
    }
#endif
}
```
